# Optimizing an MI355X kernel written in HIP

```python
import math
import jax, jax.numpy as jnp
from jax import lax
import numpy as np

D_MODEL = 1024
BATCH = 8
SEQ = 2048
DEPTH = 1
DEC_BATCH = 128
DEC_SEQ = 8
PAST_LEN = 16384
PAGE_SIZE = 128

MIX_W = D_MODEL
CONV_W = MIX_W // 2
RWKV_W = MIX_W - CONV_W
HEAD_DIM = 64
N_HEADS_RWKV = RWKV_W // HEAD_DIM
N_CONV_GROUPS = CONV_W // HEAD_DIM
CONV_K = 3
DECAY_LORA = 64
A_LORA = 64
CONV_COLS = 4 * CONV_W
RWKV_COLS = 4 * RWKV_W + DECAY_LORA + A_LORA
IN_COLS = CONV_COLS + RWKV_COLS
RMS_EPS = 1e-6
GN_EPS = 64e-5
DECAY_SCALE = math.exp(-0.5)

kernel_name = "hybrid_shortconv_rwkv7_decode_step"


def rms_norm(x, g):
    xf = x.astype(jnp.float32)
    y = xf * lax.rsqrt(jnp.mean(xf * xf, axis=-1, keepdims=True) + RMS_EPS)
    return (y * g.astype(jnp.float32)).astype(x.dtype)


def wkv7_scan(r, w, k, v, kk, a, s0):
    def step(S, inp):
        r_t, w_t, k_t, v_t, kk_t, a_t = inp
        sa = jnp.einsum('bhij,bhj->bhi', S, -kk_t)
        S = (S * w_t[:, :, None, :] + sa[..., :, None] * (kk_t * a_t)[..., None, :]
             + v_t[..., :, None] * k_t[..., None, :])
        o = jnp.einsum('bhij,bhj->bhi', S, r_t)
        return S, o
    xs = tuple(jnp.swapaxes(t, 0, 1) for t in (r, w, k, v, kk, a))
    s_fin, o = lax.scan(step, s0, xs)
    return jnp.swapaxes(o, 0, 1), s_fin


def mixer_layer(x, conv_buf, shift_prev, wkv0, norm_g, w_in, mu_shift, conv_w, w_dec2, w0,
                w_a2, a0, k_k, k_a, r_k, lnx_g, lnx_b, w_out):
    bsz, T, _ = x.shape
    xn = rms_norm(x, norm_g)
    p = xn @ w_in
    pc, pr = p[..., :CONV_COLS], p[..., CONV_COLS:]

    h = pc[..., 0:CONV_W]
    bg = pc[..., CONV_W:2 * CONV_W]
    cg = pc[..., 2 * CONV_W:3 * CONV_W]
    gc = pc[..., 3 * CONV_W:]
    u = cg * h
    u_ext = jnp.concatenate([conv_buf.astype(u.dtype), u], axis=1)
    z = (conv_w[0] * u_ext[:, 0:T] + conv_w[1] * u_ext[:, 1:T + 1]
         + conv_w[2] * u_ext[:, 2:T + 2])
    y_conv = bg * z * jax.nn.silu(gc)
    new_conv = u_ext[:, -(CONV_K - 1):]

    pr_first = shift_prev.astype(xn.dtype) @ w_in[:, CONV_COLS:]
    pr_prev = jnp.concatenate([pr_first[:, None], pr[:, :-1]], axis=1)
    pr = pr + mu_shift * (pr_prev - pr)
    new_shift = xn[:, -1]
    o0 = 3 * RWKV_W
    r = pr[..., 0:RWKV_W]
    k = pr[..., RWKV_W:2 * RWKV_W]
    v = pr[..., 2 * RWKV_W:o0]
    wl = pr[..., o0:o0 + DECAY_LORA]
    al = pr[..., o0 + DECAY_LORA:o0 + DECAY_LORA + A_LORA]
    gr = pr[..., o0 + DECAY_LORA + A_LORA:]

    f32 = jnp.float32
    decay = jnp.exp(-DECAY_SCALE * jax.nn.sigmoid((w0 + jnp.tanh(wl) @ w_dec2).astype(f32)))
    a = jax.nn.sigmoid((a0 + al @ w_a2).astype(f32))
    hs = (bsz, T, N_HEADS_RWKV, HEAD_DIM)
    rf = r.astype(f32).reshape(hs)
    kf = k.astype(f32)
    vf = v.astype(f32).reshape(hs)
    kk = (kf * k_k.astype(f32)).reshape(hs)
    kk = kk / jnp.maximum(jnp.sqrt(jnp.sum(kk * kk, axis=-1, keepdims=True)), 1e-12)
    kf = (kf * (1.0 + (a - 1.0) * k_a.astype(f32))).reshape(hs)
    af = a.reshape(hs)
    wf = decay.reshape(hs)
    o, s_fin = wkv7_scan(rf, wf, kf, vf, kk, af, wkv0.astype(f32))
    mean = jnp.mean(o, axis=-1, keepdims=True)
    var = jnp.mean(jnp.square(o - mean), axis=-1, keepdims=True)
    on = ((o - mean) * lax.rsqrt(var + GN_EPS)).reshape(bsz, T, RWKV_W)
    on = on * lnx_g.astype(f32) + lnx_b.astype(f32)
    bonus = jnp.sum(rf * kf * r_k.astype(f32), axis=-1, keepdims=True) * vf
    y_rwkv = (on + bonus.reshape(bsz, T, RWKV_W)).astype(x.dtype) * jax.nn.silu(gr)

    y = jnp.concatenate([y_conv, y_rwkv], axis=-1) @ w_out
    return x + y, new_conv, new_shift, s_fin.astype(wkv0.dtype)


def setup_inputs(seed: int = 0) -> dict:
    key = jax.random.key(seed)
    ks = jax.random.split(key, 24)
    f = jnp.float32
    nrm = lambda i, shape, s: jax.random.normal(ks[i], shape, f) * s
    return {
        "x_prompt": nrm(0, (BATCH, SEQ, D_MODEL), 1.0),
        "x_sample": nrm(1, (DEC_BATCH, DEC_SEQ, D_MODEL), 1.0),
        "state_conv": nrm(2, (DEPTH, DEC_BATCH, CONV_K - 1, CONV_W), 1.0),
        "state_shift": nrm(3, (DEPTH, DEC_BATCH, D_MODEL), 1.0),
        "state_wkv": nrm(4, (DEPTH, DEC_BATCH, N_HEADS_RWKV, HEAD_DIM, HEAD_DIM), 0.5),
        "norm_g": 1.0 + nrm(5, (DEPTH, D_MODEL), 0.02),
        "w_in": nrm(6, (DEPTH, D_MODEL, IN_COLS), D_MODEL ** -0.5),
        "mu_shift": jax.random.uniform(ks[7], (DEPTH, RWKV_COLS), f, 0.0, 1.0),
        "conv_w": nrm(8, (DEPTH, CONV_K, CONV_W), CONV_K ** -0.5),
        "w_dec2": nrm(9, (DEPTH, DECAY_LORA, RWKV_W), 0.1),
        "w0": nrm(10, (DEPTH, RWKV_W), 0.5) + 1.0,
        "w_a2": nrm(11, (DEPTH, A_LORA, RWKV_W), 0.1),
        "a0": nrm(12, (DEPTH, RWKV_W), 0.1),
        "k_k": 0.85 + nrm(13, (DEPTH, RWKV_W), 0.05),
        "k_a": 1.0 + nrm(14, (DEPTH, RWKV_W), 0.05),
        "r_k": nrm(15, (DEPTH, N_HEADS_RWKV, HEAD_DIM), 0.1),
        "lnx_g": 1.0 + nrm(16, (DEPTH, RWKV_W), 0.02),
        "lnx_b": nrm(17, (DEPTH, RWKV_W), 0.02),
        "w_out": nrm(18, (DEPTH, MIX_W, D_MODEL), MIX_W ** -0.5),
        "final_norm_g": 1.0 + nrm(19, (D_MODEL,), 0.02),
    }


def reference(x_prompt, x_sample, state_conv, state_shift, state_wkv, norm_g, w_in, mu_shift,
              conv_w, w_dec2, w0, w_a2, a0, k_k, k_a, r_k, lnx_g, lnx_b, w_out, final_norm_g):
    dt = x_prompt.dtype
    hp, hs = x_prompt, x_sample
    conv_p, shift_p, wkv_p, conv_s, shift_s, wkv_s = [], [], [], [], [], []
    for l in range(DEPTH):
        params = (norm_g[l], w_in[l], mu_shift[l], conv_w[l], w_dec2[l], w0[l], w_a2[l], a0[l],
                  k_k[l], k_a[l], r_k[l], lnx_g[l], lnx_b[l], w_out[l])
        hp, cp, sp, wp = mixer_layer(
            hp, jnp.zeros((BATCH, CONV_K - 1, CONV_W), dt), jnp.zeros((BATCH, D_MODEL), dt),
            jnp.zeros((BATCH, N_HEADS_RWKV, HEAD_DIM, HEAD_DIM), state_wkv.dtype), *params)
        hs, cs, ss, ws = mixer_layer(hs, state_conv[l], state_shift[l], state_wkv[l], *params)
        conv_p.append(cp); shift_p.append(sp); wkv_p.append(wp)
        conv_s.append(cs); shift_s.append(ss); wkv_s.append(ws)
    y_prompt = rms_norm(hp, final_norm_g)
    y_sample = rms_norm(hs, final_norm_g)
    return (y_prompt, y_sample, jnp.stack(conv_p), jnp.stack(shift_p), jnp.stack(wkv_p),
            jnp.stack(conv_s), jnp.stack(shift_s), jnp.stack(wkv_s))
```

```cpp
#include <hip/hip_runtime.h>
#include <hip/hip_cooperative_groups.h>
#include <cstdio>
namespace cg = cooperative_groups;
namespace pg8 {
#define PG8_LAS __attribute__((address_space(3)))
typedef unsigned short bf16_t;
typedef short bf16x8 __attribute__((ext_vector_type(8)));
typedef float f32x4 __attribute__((ext_vector_type(4)));
typedef unsigned u32x4 __attribute__((ext_vector_type(4)));
constexpr int BM = 256, BK = 64, HALF = 128, HTB = HALF * BK * 2  , STAGE_BYTES = 8 * HTB, NXCD = 8, WGM = 8;

__host__ __device__ __forceinline__ int lds_byte(int r, int c) { const int st = (r >> 4) * 2 + (c >> 5), rr = r & 15, cc = c & 31, ob = rr * 64 + cc * 2; return st * 1024 + (ob ^ (((ob >> 9) & 1) << 5)); }
__host__ __device__ __forceinline__ void stage_rc(int b, int& R, int& C) { const int st = b / 1024, sb = b % 1024, swz = sb ^ (((sb >> 9) & 1) << 5); R = (st >> 1) * 16 + swz / 64; C = (st & 1) * 32 + (swz % 64) / 2; }
__host__ __device__ __forceinline__ int perm32(int rho) { const int n = rho >> 4, i = rho & 15; return 8 * (i >> 2) + 4 * n + (i & 3); }

struct Unit { int pm, pn; };
struct Gemm { const bf16_t* A; const bf16_t* Bt; int M, N, K; };

struct StaticOrder {
    int nM, nN, nwg, G, c;
    __host__ __device__ void init(int M, int N, int G_, int c_) { nM = M / BM; nN = N / BM; nwg = nM * nN; G = G_; c = c_; }
    __host__ __device__ bool next(int i, Unit& u) const {
        const long L = (long)i * G + c; if (L >= nwg) return false;
        int wgid = (int)L; { const int q = nwg / NXCD, r = nwg % NXCD, xcd = wgid % NXCD, off = wgid / NXCD; wgid = (xcd < r ? xcd * (q + 1) : r * (q + 1) + (xcd - r) * q) + off; }
        const int nig = WGM * nN, gid = wgid / nig, fm = gid * WGM, gsz = (nM - fm) < WGM ? (nM - fm) : WGM;
        u.pm = fm + ((wgid % nig) % gsz); u.pn = (wgid % nig) / gsz; return true;
    }
    __device__ __forceinline__ void a_ready(const Unit&) const {}
    __device__ __forceinline__ void done(const Unit&) const {}
};
struct CountedOrder : StaticOrder {
    const unsigned* ready; unsigned need; unsigned* tmo;
    __device__ __forceinline__ void a_ready(const Unit& u) const {
        if (threadIdx.x < 64) {
            const unsigned long long t0 = __builtin_amdgcn_s_memrealtime(); unsigned polls = 0;
            while ((unsigned)__builtin_amdgcn_readfirstlane(__hip_atomic_load(ready + 64 * u.pm, __ATOMIC_RELAXED, __HIP_MEMORY_SCOPE_AGENT)) < need) {
                if ((++polls & 255u) == 0u && __builtin_amdgcn_readfirstlane(__hip_atomic_load(tmo, __ATOMIC_RELAXED, __HIP_MEMORY_SCOPE_AGENT)) != 0u) break;
                if (__builtin_amdgcn_s_memrealtime() - t0 > 2000000ull) {
                    if (threadIdx.x == 0) { unsigned expect = 0u; __hip_atomic_compare_exchange_strong(tmo + 1, &expect, 0x600u | (unsigned)(u.pm & 0xff), __ATOMIC_RELAXED, __ATOMIC_RELAXED, __HIP_MEMORY_SCOPE_AGENT); __hip_atomic_store(tmo, 1u, __ATOMIC_RELAXED, __HIP_MEMORY_SCOPE_AGENT); }
                    break; }
                __builtin_amdgcn_s_sleep(2); }
            __builtin_amdgcn_fence(__ATOMIC_ACQUIRE, "agent");
            asm volatile("s_waitcnt vmcnt(0)" ::: "memory");
        }
#if !defined(BROKEN_HOOK_NO_BARRIER)
        asm volatile("" ::: "memory"); __builtin_amdgcn_s_barrier(); asm volatile("" ::: "memory");
#endif
    }
};

__device__ __forceinline__ unsigned cvt_pk_bf16(float lo, float hi) { unsigned r; asm volatile("v_cvt_pk_bf16_f32 %0, %1, %2" : "=v"(r) : "v"(lo), "v"(hi)); return r; }
typedef float f32x2 __attribute__((ext_vector_type(2)));
__device__ __forceinline__ f32x2 gelu_pk(f32x2 v) {
    const f32x2 av = __builtin_elementwise_abs(v), d = av * 0.2316418882f + 1.0f;
    f32x2 t; t.x = __builtin_amdgcn_rcpf(d.x); t.y = __builtin_amdgcn_rcpf(d.y);
    f32x2 q = t * 0.5307027145f + (-0.7265760135f); q = q * t + 0.7107068705f; q = q * t + (-0.142248368f); q = q * t + 0.127414796f; q = q * t;
    const f32x2 s = (v * v) * (-0.72134752044f);
    f32x2 e; e.x = __builtin_amdgcn_exp2f(s.x); e.y = __builtin_amdgcn_exp2f(s.y);
    const f32x2 m = v * (q * e), r = v - m;
    f32x2 o; o.x = v.x < 0.f ? m.x : r.x; o.y = v.y < 0.f ? m.y : r.y; return o;
}

struct EpiF32 {
    static constexpr bool PERM = false, AFTER_DRAIN = false;
    float* C; int ldc; const float* bias;
    __device__ __forceinline__ void operator()(const f32x4 (&acc)[2][2][4][2], const Unit& u, int wr, int wc, int fr, int fq) const {
        const int row0 = u.pm * BM + wr * 64 + fr, col0 = u.pn * BM + wc * 32 + 4 * fq;
        f32x4 bv[2][2];
#pragma unroll
        for (int bj = 0; bj < 2; ++bj)
#pragma unroll
            for (int n = 0; n < 2; ++n) bv[bj][n] = bias ? *(const f32x4*)(bias + col0 + bj * HALF + n * 16) : (f32x4){0.f, 0.f, 0.f, 0.f};
#pragma unroll
        for (int ai = 0; ai < 2; ++ai)
#pragma unroll
            for (int m = 0; m < 4; ++m) { float* rowp = C + (size_t)(row0 + ai * HALF + m * 16) * ldc + col0;
#pragma unroll
                for (int bj = 0; bj < 2; ++bj)
#pragma unroll
                    for (int n = 0; n < 2; ++n) *(f32x4*)(rowp + bj * HALF + n * 16) = acc[ai][bj][m][n] + bv[bj][n]; }
    }
};
template <int ACT  > struct EpiBf16 {
    static constexpr bool PERM = true, AFTER_DRAIN = false;
    bf16_t* O; int ldc; const float* bias; int split_cols; size_t split_stride;
    __device__ __forceinline__ void operator()(const f32x4 (&acc)[2][2][4][2], const Unit& u, int wr, int wc, int fr, int fq) const {
        const int row0 = u.pm * BM + wr * 64 + fr; int colt = u.pn * BM; bf16_t* base = O;
        if (split_cols) { const int t = colt / split_cols; base += (size_t)t * split_stride; colt -= t * split_cols; }
        const int col0 = colt + wc * 32 + 8 * fq, bcol0 = u.pn * BM + wc * 32 + 8 * fq;
        f32x4 bv[2][2];
#pragma unroll
        for (int bj = 0; bj < 2; ++bj)
#pragma unroll
            for (int n = 0; n < 2; ++n) bv[bj][n] = bias ? *(const f32x4*)(bias + bcol0 + bj * HALF + 4 * n) : (f32x4){0.f, 0.f, 0.f, 0.f};
#pragma unroll
        for (int ai = 0; ai < 2; ++ai)
#pragma unroll
            for (int m = 0; m < 4; ++m) { bf16_t* rowp = base + (size_t)(row0 + ai * HALF + m * 16) * ldc + col0;
#pragma unroll
                for (int bj = 0; bj < 2; ++bj) { f32x4 v0 = acc[ai][bj][m][0] + bv[bj][0], v1 = acc[ai][bj][m][1] + bv[bj][1];
                    if (ACT == 1) { f32x2 a = gelu_pk((f32x2){v0[0], v0[1]}), b = gelu_pk((f32x2){v0[2], v0[3]}), c = gelu_pk((f32x2){v1[0], v1[1]}), d = gelu_pk((f32x2){v1[2], v1[3]});
                        v0 = (f32x4){a.x, a.y, b.x, b.y}; v1 = (f32x4){c.x, c.y, d.x, d.y}; }
                    if (ACT == 2) {
#pragma unroll
                        for (int j = 0; j < 4; ++j) { v0[j] = 0.5f * v0[j] * (1.0f + erff(v0[j] * 0.70710678f)); v1[j] = 0.5f * v1[j] * (1.0f + erff(v1[j] * 0.70710678f)); } }
                    u32x4 w; w.x = cvt_pk_bf16(v0[0], v0[1]); w.y = cvt_pk_bf16(v0[2], v0[3]); w.z = cvt_pk_bf16(v1[0], v1[1]); w.w = cvt_pk_bf16(v1[2], v1[3]);
                    *(u32x4*)(rowp + bj * HALF) = w; } }
    }
};
template <class Epi, class Sched, bool STAMP = false>
__device__ __forceinline__ void gemm_phase(PG8_LAS unsigned char* lds, const Gemm g, const Sched& S, const Epi& E, unsigned long long* stamps) {
    const int tid = threadIdx.x, wid = __builtin_amdgcn_readfirstlane(tid >> 6), lane = tid & 63, wr = wid >> 2, wc = wid & 3, fr = lane & 15, fq = lane >> 4;
    const int K = g.K, nt = K / BK;
    int ts_lo = 0, ts_hi = 0, nts = 0; const unsigned long long rt_entry = STAMP ? (unsigned long long)wall_clock64() : 0ull;
#define PG8_STAMP() do { if (STAMP && wid == 0 && nts < 64) { const unsigned long long _c = (unsigned long long)clock64(); \
        ts_lo = (lane == nts) ? (int)(unsigned)_c : ts_lo; ts_hi = (lane == nts) ? (int)(unsigned)(_c >> 32) : ts_hi; ++nts; } } while (0)
    PG8_STAMP();
    unsigned voffA[2], voffB[2];
#pragma unroll
    for (int i = 0; i < 2; ++i) { int R, C; stage_rc(tid * 16 + i * 8192, R, C); const int Rb = Epi::PERM ? ((R & ~31) + perm32(R & 31)) : R;
        voffA[i] = (unsigned)(R * K + C) * 2u; voffB[i] = (unsigned)(Rb * K + C) * 2u; }
    const size_t kstep = (size_t)(BK * 2);
    const size_t hstep = (size_t)HALF * K * 2;
    const size_t tstep = 2 * hstep;
    const unsigned ldsw = (unsigned)wid * 1024u;
    const int aoff = lds_byte(wr * 64 + fr, fq * 8), boff = lds_byte(wc * 32 + fr, fq * 8);
#define PG8_SA(b, h) (((b) * 2 + (h)) * HTB)
#define PG8_SB(b, h) ((4 + (b) * 2 + (h)) * HTB)
#define PG8_STAGE(bufoff, gbase, voff) do { _Pragma("unroll") for (int _i = 0; _i < 2; ++_i) \
        __builtin_amdgcn_global_load_lds((const unsigned*)((const char*)(gbase) + (voff)[_i]), (PG8_LAS unsigned*)(lds + (bufoff) + ldsw + _i * 8192), 16, 0, 0); } while (0)
#define PG8_LDA(dst, b, h) do { _Pragma("unroll") for (int m = 0; m < 4; ++m) _Pragma("unroll") for (int k = 0; k < 2; ++k) dst[m][k] = *(const PG8_LAS bf16x8*)(lds + PG8_SA(b, h) + aoff + m * 2048 + k * 1024); } while (0)
#define PG8_LDB(dst, b, h) do { _Pragma("unroll") for (int n = 0; n < 2; ++n) _Pragma("unroll") for (int k = 0; k < 2; ++k) dst[n][k] = *(const PG8_LAS bf16x8*)(lds + PG8_SB(b, h) + boff + n * 2048 + k * 1024); } while (0)
#define PG8_MMA(ai, bj, At, Bt) do { __builtin_amdgcn_s_setprio(1); _Pragma("unroll") for (int m = 0; m < 4; ++m) _Pragma("unroll") for (int n = 0; n < 2; ++n) _Pragma("unroll") for (int k = 0; k < 2; ++k) \
        acc[ai][bj][m][n] = __builtin_amdgcn_mfma_f32_16x16x32_bf16(Bt[n][k], At[m][k], acc[ai][bj][m][n], 0, 0, 0); __builtin_amdgcn_s_setprio(0); } while (0)
#define PG8_WAIT_V(n) asm volatile("s_waitcnt vmcnt(" #n ")" ::: "memory")
#define PG8_WAIT_L(n) asm volatile("s_waitcnt lgkmcnt(" #n ")" ::: "memory")
#define PG8_BAR __builtin_amdgcn_s_barrier()
#define PG8_SCHED __builtin_amdgcn_sched_barrier(0)
    Unit cur, nxt; int ui = 0;
    if (!S.next(0, cur)) return;
    f32x4 acc[2][2][4][2];
#pragma unroll
    for (int a = 0; a < 2; ++a)
#pragma unroll
        for (int b = 0; b < 2; ++b)
#pragma unroll
            for (int m = 0; m < 4; ++m)
#pragma unroll
                for (int n = 0; n < 2; ++n) acc[a][b][m][n] = (f32x4){0.f, 0.f, 0.f, 0.f};
    bf16x8 At[4][2], B0[2][2], B1[2][2];
    const char* cA = (const char*)g.A + (size_t)cur.pm * tstep; const char* cB = (const char*)g.Bt + (size_t)cur.pn * tstep;
    S.a_ready(cur);
    PG8_STAGE(PG8_SB(0, 0), cB, voffB); PG8_STAGE(PG8_SA(0, 0), cA, voffA); PG8_STAGE(PG8_SB(0, 1), cB + hstep, voffB); PG8_STAGE(PG8_SA(0, 1), cA + hstep, voffA);
    if (wr == 1) PG8_BAR;
    PG8_WAIT_V(4); PG8_BAR;
    PG8_STAGE(PG8_SB(1, 0), cB + kstep, voffB); PG8_STAGE(PG8_SA(1, 0), cA + kstep, voffA); PG8_STAGE(PG8_SB(1, 1), cB + hstep + kstep, voffB);
    PG8_WAIT_V(6); PG8_BAR;
    PG8_STAMP();
    for (;;) {
        const bool has_next = S.next(ui + 1, nxt);
        const char* nA = has_next ? (const char*)g.A + (size_t)nxt.pm * tstep : cA; const char* nB = has_next ? (const char*)g.Bt + (size_t)nxt.pn * tstep : cB;
        for (int t = 0; t < nt; t += 2) {
            const bool last = (t == nt - 2);
            const char* a1 = cA + (size_t)(t + 1) * kstep;
            const char* a2 = last ? nA : cA + (size_t)(t + 2) * kstep; const char* b2 = last ? nB : cB + (size_t)(t + 2) * kstep;
            const char* a3 = a2 + kstep; const char* b3 = b2 + kstep;
            if (last && has_next) S.a_ready(nxt);
            PG8_LDB(B0, 0, 0); PG8_SCHED; PG8_LDA(At, 0, 0); PG8_STAGE(PG8_SA(1, 1), a1 + hstep, voffA);
            PG8_WAIT_L(8); PG8_BAR; PG8_WAIT_L(0); PG8_MMA(0, 0, At, B0); PG8_BAR; PG8_SCHED;
            PG8_LDB(B1, 0, 1); PG8_STAGE(PG8_SB(0, 0), b2, voffB);
            PG8_BAR; PG8_WAIT_L(0); PG8_MMA(0, 1, At, B1); PG8_BAR;
            PG8_LDA(At, 0, 1); PG8_STAGE(PG8_SA(0, 0), a2, voffA);
            PG8_BAR; PG8_WAIT_L(0); PG8_MMA(1, 0, At, B0); PG8_BAR; PG8_SCHED;
            PG8_STAGE(PG8_SB(0, 1), b2 + hstep, voffB);
            PG8_WAIT_V(6); PG8_BAR; PG8_MMA(1, 1, At, B1); PG8_BAR;
            PG8_LDB(B0, 1, 0); PG8_SCHED; PG8_LDA(At, 1, 0); PG8_STAGE(PG8_SA(0, 1), a2 + hstep, voffA);
            PG8_WAIT_L(8); PG8_BAR; PG8_WAIT_L(0); PG8_MMA(0, 0, At, B0); PG8_BAR; PG8_SCHED;
            PG8_LDB(B1, 1, 1); PG8_STAGE(PG8_SB(1, 0), b3, voffB);
            PG8_BAR; PG8_WAIT_L(0); PG8_MMA(0, 1, At, B1); PG8_BAR;
            PG8_LDA(At, 1, 1); PG8_STAGE(PG8_SA(1, 0), a3, voffA);
            PG8_BAR; PG8_WAIT_L(0); PG8_MMA(1, 0, At, B0); PG8_BAR; PG8_SCHED;
            PG8_STAGE(PG8_SB(1, 1), b3 + hstep, voffB);
            PG8_WAIT_V(6); PG8_BAR; PG8_MMA(1, 1, At, B1); PG8_BAR;
        }
        PG8_STAMP();
        if constexpr (!Epi::AFTER_DRAIN) { E(acc, cur, wr, wc, fr, fq); S.done(cur); }
        PG8_STAMP();
        if (!has_next) break;
#pragma unroll
        for (int a = 0; a < 2; ++a)
#pragma unroll
            for (int b = 0; b < 2; ++b)
#pragma unroll
                for (int m = 0; m < 4; ++m)
#pragma unroll
                    for (int n = 0; n < 2; ++n) acc[a][b][m][n] = (f32x4){0.f, 0.f, 0.f, 0.f};
        cur = nxt; cA = nA; cB = nB; ++ui;
    }
    PG8_WAIT_V(0);
    if (wr == 0) PG8_BAR;
    PG8_BAR;
    if constexpr (Epi::AFTER_DRAIN) { E.fused(acc, cur, wr, wc, fr, fq, lds, wid, lane); S.done(cur); }
    PG8_STAMP();
    if (STAMP && wid == 0) { stamps[lane] = lane < nts ? (((unsigned long long)(unsigned)ts_hi << 32) | (unsigned)ts_lo) : 0ull;
        if (lane == 62) stamps[62] = rt_entry; if (lane == 63) stamps[63] = (unsigned long long)wall_clock64(); }
#undef PG8_STAMP
#undef PG8_SA
#undef PG8_SB
#undef PG8_STAGE
#undef PG8_LDA
#undef PG8_LDB
#undef PG8_MMA
#undef PG8_WAIT_V
#undef PG8_WAIT_L
#undef PG8_BAR
#undef PG8_SCHED
}
}
using pg8::bf16_t; using pg8::f32x4; using pg8::cvt_pk_bf16;
typedef unsigned u32x2 __attribute__((ext_vector_type(2)));
typedef unsigned u32x4v __attribute__((ext_vector_type(4)));
constexpr int D = 1024, MPR = 16384, MTOK = 17408, MROWS = 17664, INC = 4224, NP = 4352, SEQ = 2048, DSEQ = 8, NDB = 128, NH = 8;
constexpr int RC = 2048;
constexpr size_t OFF_YS = (size_t)MPR * D, OFF_CONVP = OFF_YS + 1024 * 1024, OFF_SHIFTP = OFF_CONVP + 8192, OFF_WKVP = OFF_SHIFTP + 8192,
                 OFF_CONVS = OFF_WKVP + 262144, OFF_SHIFTS = OFF_CONVS + 131072, OFF_WKVS = OFF_SHIFTS + 131072;
constexpr size_t WS_XN = 0, WS_W1 = WS_XN + (size_t)MROWS * D * 2, WS_W2 = WS_W1 + (size_t)NP * D * 2, WS_P = WS_W2 + (size_t)D * D * 2,
                 WS_YC = WS_P + (size_t)MROWS * NP * 2, WS_SS = WS_YC + (size_t)MTOK * D * 2, WS_END = WS_SS + (size_t)MTOK * 4;
constexpr int LDS_BYTES = 131072;

struct Params {
    const float *x_prompt, *x_sample, *state_conv, *state_shift, *state_wkv, *norm_g, *w_in, *mu_shift, *conv_w, *w_dec2, *w0, *w_a2, *a0, *k_k, *k_a, *r_k, *lnx_g, *lnx_b, *w_out, *final_g;
    float* out; unsigned char* ws;
};

__device__ __forceinline__ float bf2f(unsigned short b) { return __uint_as_float(((unsigned)b) << 16); }
__device__ __forceinline__ float bflo(unsigned w) { return __uint_as_float(w << 16); }
__device__ __forceinline__ float bfhi(unsigned w) { return __uint_as_float(w & 0xffff0000u); }
__device__ __forceinline__ float sigmoidf_(float x) { return 1.0f / (1.0f + __expf(-x)); }
__device__ __forceinline__ float siluf_(float x) { return x / (1.0f + __expf(-x)); }

__device__ void phase0(const Params& p, unsigned char* lds) {
    const int tid = threadIdx.x, nb = gridDim.x, bid = blockIdx.x, wid = tid >> 6, lane = tid & 63;
    float* tile = (float*)lds;
    bf16_t* W1 = (bf16_t*)(p.ws + WS_W1); bf16_t* W2 = (bf16_t*)(p.ws + WS_W2); bf16_t* XN = (bf16_t*)(p.ws + WS_XN); float* SS = (float*)(p.ws + WS_SS);
    for (int it = bid; it < 1088 + 256; it += nb) {
        const float* src; bf16_t* dst; int ncs, n0, k0;
        if (it < 1088) { const int kt = it / 68, nt = it % 68; src = p.w_in; ncs = INC; dst = W1; n0 = nt * 64; k0 = kt * 64; }
        else { const int j = it - 1088, kt = j >> 4, nt = j & 15; src = p.w_out; ncs = D; dst = W2; n0 = nt * 64; k0 = kt * 64; }
#pragma unroll
        for (int e = 0; e < 8; ++e) { const int idx = e * 512 + tid, kk = idx >> 6, nn = idx & 63, n = n0 + nn; tile[kk * 65 + nn] = (n < ncs) ? src[(size_t)(k0 + kk) * ncs + n] : 0.f; }
        __syncthreads();
#pragma unroll
        for (int e = 0; e < 4; ++e) { const int idx = e * 512 + tid, nn = idx >> 5, kp = idx & 31; *(unsigned*)(dst + (size_t)(n0 + nn) * D + k0 + 2 * kp) = cvt_pk_bf16(tile[(2 * kp) * 65 + nn], tile[(2 * kp + 1) * 65 + nn]); }
        __syncthreads();
    }
    for (int i = bid * 512 + tid; i < MTOK; i += nb * 512) SS[i] = 0.f;
    for (int row = bid * 8 + wid; row < MROWS; row += nb * 8) {
        bf16_t* xo = XN + (size_t)row * D;
        if (row < MTOK) {
            const float* xr = row < MPR ? p.x_prompt + (size_t)row * D : p.x_sample + (size_t)(row - MPR) * D;
            f32x4 v[4]; float s = 0.f;
#pragma unroll
            for (int i = 0; i < 4; ++i) { v[i] = *(const f32x4*)(xr + (lane + 64 * i) * 4); s += v[i][0] * v[i][0] + v[i][1] * v[i][1] + v[i][2] * v[i][2] + v[i][3] * v[i][3]; }
#pragma unroll
            for (int o = 32; o >= 1; o >>= 1) s += __shfl_xor(s, o);
            const float rs = rsqrtf(s * (1.0f / 1024.0f) + 1e-6f);
            float* sh = nullptr;
            if (row < MPR) { if ((row & (SEQ - 1)) == SEQ - 1) sh = p.out + OFF_SHIFTP + (size_t)(row >> 11) * D; }
            else { const int rs_ = row - MPR; if ((rs_ & 7) == 7) sh = p.out + OFF_SHIFTS + (size_t)(rs_ >> 3) * D; }
#pragma unroll
            for (int i = 0; i < 4; ++i) { const int c = (lane + 64 * i) * 4; const f32x4 g = *(const f32x4*)(p.norm_g + c); const f32x4 y = v[i] * rs * g;
                u32x2 w; w.x = cvt_pk_bf16(y[0], y[1]); w.y = cvt_pk_bf16(y[2], y[3]); *(u32x2*)(xo + c) = w; if (sh) *(f32x4*)(sh + c) = y; }
        } else if (row < MTOK + NDB) {
            const float* xr = p.state_shift + (size_t)(row - MTOK) * D;
#pragma unroll
            for (int i = 0; i < 4; ++i) { const int c = (lane + 64 * i) * 4; const f32x4 y = *(const f32x4*)(xr + c); u32x2 w; w.x = cvt_pk_bf16(y[0], y[1]); w.y = cvt_pk_bf16(y[2], y[3]); *(u32x2*)(xo + c) = w; }
        } else {
#pragma unroll
            for (int i = 0; i < 4; ++i) { const int c = (lane + 64 * i) * 4; u32x2 w; w.x = 0u; w.y = 0u; *(u32x2*)(xo + c) = w; }
        }
    }
}

__device__ __forceinline__ void ld8(const bf16_t* ptr, float (&f)[8]) { const u32x4v w = *(const u32x4v*)ptr; f[0] = bflo(w.x); f[1] = bfhi(w.x); f[2] = bflo(w.y); f[3] = bfhi(w.y); f[4] = bflo(w.z); f[5] = bfhi(w.z); f[6] = bflo(w.w); f[7] = bfhi(w.w); }
__device__ void conv_items(const Params& p) {
    const int tid = threadIdx.x, nb = gridDim.x, bid = blockIdx.x;
    const bf16_t* P = (const bf16_t*)(p.ws + WS_P); bf16_t* YC = (bf16_t*)(p.ws + WS_YC);
    const int c0 = (tid & 63) * 8;
    float cw0[8], cw1[8], cw2[8];
#pragma unroll
    for (int j = 0; j < 8; ++j) { cw0[j] = p.conv_w[c0 + j]; cw1[j] = p.conv_w[512 + c0 + j]; cw2[j] = p.conv_w[1024 + c0 + j]; }
    for (int it = bid; it < MTOK / 8; it += nb) {
        const int R = it * 8 + (tid >> 6);
        int t, T; const float* cbuf; float* cout;
        if (R < MPR) { const int b = R >> 11; t = R & (SEQ - 1); T = SEQ; cbuf = nullptr; cout = p.out + OFF_CONVP + (size_t)b * 1024; }
        else { const int rs = R - MPR, b = rs >> 3; t = rs & 7; T = DSEQ; cbuf = p.state_conv + (size_t)b * 1024; cout = p.out + OFF_CONVS + (size_t)b * 1024; }
        const bf16_t* pr = P + (size_t)R * NP + c0;
        float hh[8], cc[8], u0[8], u1[8], u2[8], bg[8], gg[8];
        ld8(pr, hh); ld8(pr + 1024, cc);
#pragma unroll
        for (int j = 0; j < 8; ++j) u0[j] = cc[j] * hh[j];
        if (t >= 1) { ld8(pr - NP, hh); ld8(pr - NP + 1024, cc);
#pragma unroll
            for (int j = 0; j < 8; ++j) u1[j] = cc[j] * hh[j]; }
        else {
#pragma unroll
            for (int j = 0; j < 8; ++j) u1[j] = cbuf ? cbuf[512 + c0 + j] : 0.f; }
        if (t >= 2) { ld8(pr - 2 * NP, hh); ld8(pr - 2 * NP + 1024, cc);
#pragma unroll
            for (int j = 0; j < 8; ++j) u2[j] = cc[j] * hh[j]; }
        else {
#pragma unroll
            for (int j = 0; j < 8; ++j) u2[j] = cbuf ? cbuf[t * 512 + c0 + j] : 0.f; }
        ld8(pr + 512, bg); ld8(pr + 1536, gg);
        float y[8];
#pragma unroll
        for (int j = 0; j < 8; ++j) { const float z = cw0[j] * u2[j] + cw1[j] * u1[j] + cw2[j] * u0[j]; y[j] = bg[j] * z * siluf_(gg[j]); }
        u32x4v w; w.x = cvt_pk_bf16(y[0], y[1]); w.y = cvt_pk_bf16(y[2], y[3]); w.z = cvt_pk_bf16(y[4], y[5]); w.w = cvt_pk_bf16(y[6], y[7]);
        *(u32x4v*)(YC + (size_t)R * D + c0) = w;
        if (t >= T - 2) { float* co = cout + (t - (T - 2)) * 512 + c0;
#pragma unroll
            for (int j = 0; j < 8; ++j) co[j] = u0[j]; }
    }
}

__device__ void scan_item(const Params& p, unsigned char* lds, int rowbase, int T, int shiftrow, int h, const float* s_in, float* s_out) {
    const int tid = threadIdx.x;
    const bf16_t* P = (const bf16_t*)(p.ws + WS_P); bf16_t* YC = (bf16_t*)(p.ws + WS_YC);
    float* LR = (float*)lds; float* LK = LR + 2048; float* LV = LK + 2048; float* LG = LV + 2048; float* LWL = LG + 2048; float* LAL = LWL + 2048;
    float* LW = LAL + 2048; float* LKK = LW + 2048; float* LBB = LKK + 2048; float* LO = LBB + 2048; float* LBON = LO + 2048;
    const int i_ = tid >> 2, q_ = tid & 3;
    const int t_ = tid >> 4, j0 = (tid & 15) * 4;
    float s[16];
    if (tid < 256) {
#pragma unroll
        for (int j = 0; j < 16; ++j) s[j] = s_in ? s_in[i_ * 64 + q_ * 16 + j] : 0.f;
    }
    const int hc = h * 64 + j0;
    for (int t0 = 0; t0 < T; t0 += 32) {
        const int n = (T - t0) < 32 ? (T - t0) : 32;
        if (t_ < n) {
            const int R = rowbase + t0 + t_; const int Rp = (t0 + t_ == 0) ? shiftrow : R - 1;
            const bf16_t* pc = P + (size_t)R * NP + RC; const bf16_t* pp = Rp >= 0 ? P + (size_t)Rp * NP + RC : nullptr;
            const int cols[6] = {hc, 512 + hc, 1024 + hc, 1664 + hc, 1536 + j0, 1600 + j0};
            float* dsts[6] = {LR, LK, LV, LG, LWL, LAL};
#pragma unroll
            for (int a = 0; a < 6; ++a) {
                const u32x2 c = *(const u32x2*)(pc + cols[a]); u32x2 pv; pv.x = 0u; pv.y = 0u; if (pp) pv = *(const u32x2*)(pp + cols[a]);
                const f32x4 mu = *(const f32x4*)(p.mu_shift + cols[a]);
                float cv[4] = {bflo(c.x), bfhi(c.x), bflo(c.y), bfhi(c.y)}, pvv[4] = {bflo(pv.x), bfhi(pv.x), bflo(pv.y), bfhi(pv.y)};
                f32x4 m;
#pragma unroll
                for (int e = 0; e < 4; ++e) m[e] = cv[e] + mu[e] * (pvv[e] - cv[e]);
                if (a == 4) {
#pragma unroll
                    for (int e = 0; e < 4; ++e) m[e] = tanhf(m[e]); }
                *(f32x4*)(dsts[a] + t_ * 64 + j0) = m;
            }
        }
        __syncthreads();
        if (t_ < n) {
            f32x4 dp = *(const f32x4*)(p.w0 + hc), ap = *(const f32x4*)(p.a0 + hc);
            for (int l = 0; l < 64; ++l) { const float wl = LWL[t_ * 64 + l], al = LAL[t_ * 64 + l];
                dp += wl * *(const f32x4*)(p.w_dec2 + l * 512 + hc); ap += al * *(const f32x4*)(p.w_a2 + l * 512 + hc); }
            const f32x4 kv = *(const f32x4*)(LK + t_ * 64 + j0), rv = *(const f32x4*)(LR + t_ * 64 + j0);
            const f32x4 kkw = *(const f32x4*)(p.k_k + hc), kaw = *(const f32x4*)(p.k_a + hc), rkw = *(const f32x4*)(p.r_k + hc);
            f32x4 dec, av, kk, km; float ss = 0.f, bon = 0.f;
#pragma unroll
            for (int e = 0; e < 4; ++e) { dec[e] = __expf(-0.6065306597126334f * sigmoidf_(dp[e])); av[e] = sigmoidf_(ap[e]); kk[e] = kv[e] * kkw[e]; ss += kk[e] * kk[e];
                km[e] = kv[e] * (1.0f + (av[e] - 1.0f) * kaw[e]); bon += rv[e] * km[e] * rkw[e]; }
#pragma unroll
            for (int o = 8; o >= 1; o >>= 1) { ss += __shfl_xor(ss, o); bon += __shfl_xor(bon, o); }
            const float inv = 1.0f / fmaxf(sqrtf(ss), 1e-12f);
            f32x4 kkn = kk * inv, bb;
#pragma unroll
            for (int e = 0; e < 4; ++e) bb[e] = kkn[e] * av[e];
            *(f32x4*)(LW + t_ * 64 + j0) = dec; *(f32x4*)(LK + t_ * 64 + j0) = km; *(f32x4*)(LKK + t_ * 64 + j0) = kkn; *(f32x4*)(LBB + t_ * 64 + j0) = bb;
            if ((tid & 15) == 0) LBON[t_] = bon;
        }
        __syncthreads();
        if (tid < 256) {
            for (int t = 0; t < n; ++t) {
                const float* bw = LW + t * 64 + q_ * 16; const float* bk = LK + t * 64 + q_ * 16; const float* bkk = LKK + t * 64 + q_ * 16; const float* bbb = LBB + t * 64 + q_ * 16; const float* br = LR + t * 64 + q_ * 16;
                const float vi = LV[t * 64 + i_];
                float sa = 0.f;
#pragma unroll
                for (int j = 0; j < 16; ++j) sa -= s[j] * bkk[j];
                sa += __shfl_xor(sa, 1); sa += __shfl_xor(sa, 2);
                float o = 0.f;
#pragma unroll
                for (int j = 0; j < 16; ++j) { s[j] = s[j] * bw[j] + sa * bbb[j] + vi * bk[j]; o += s[j] * br[j]; }
                o += __shfl_xor(o, 1); o += __shfl_xor(o, 2);
                if (q_ == 0) LO[t * 64 + i_] = o;
            }
        }
        __syncthreads();
        if (t_ < n) {
            const f32x4 o = *(const f32x4*)(LO + t_ * 64 + j0);
            float sm = o[0] + o[1] + o[2] + o[3];
#pragma unroll
            for (int of = 8; of >= 1; of >>= 1) sm += __shfl_xor(sm, of);
            const float mean = sm * (1.0f / 64.0f);
            const f32x4 dv = o - mean; float vs = dv[0] * dv[0] + dv[1] * dv[1] + dv[2] * dv[2] + dv[3] * dv[3];
#pragma unroll
            for (int of = 8; of >= 1; of >>= 1) vs += __shfl_xor(vs, of);
            const float rstd = rsqrtf(vs * (1.0f / 64.0f) + 64e-5f);
            const f32x4 lg = *(const f32x4*)(p.lnx_g + hc), lb = *(const f32x4*)(p.lnx_b + hc), vv = *(const f32x4*)(LV + t_ * 64 + j0), gv = *(const f32x4*)(LG + t_ * 64 + j0);
            const float bon = LBON[t_];
            float y[4];
#pragma unroll
            for (int e = 0; e < 4; ++e) y[e] = (dv[e] * rstd * lg[e] + lb[e] + bon * vv[e]) * siluf_(gv[e]);
            u32x2 w; w.x = cvt_pk_bf16(y[0], y[1]); w.y = cvt_pk_bf16(y[2], y[3]);
            *(u32x2*)(YC + (size_t)(rowbase + t0 + t_) * D + 512 + hc) = w;
        }
        __syncthreads();
    }
    if (tid < 256) {
#pragma unroll
        for (int j = 0; j < 16; j += 4) *(f32x4*)(s_out + i_ * 64 + q_ * 16 + j) = (f32x4){s[j], s[j + 1], s[j + 2], s[j + 3]};
    }
}

__device__ void phase2(const Params& p, unsigned char* lds) {
    const int nb = gridDim.x, bid = blockIdx.x;
    if (bid < 64) { for (int it = bid; it < 64; it += nb) { const int b = it >> 3, h = it & 7; scan_item(p, lds, b * SEQ, SEQ, -1, h, nullptr, p.out + OFF_WKVP + (size_t)it * 4096); } }
    const int nrest = nb > 64 ? nb - 64 : nb, rid = nb > 64 ? bid - 64 : bid;
    if (nb <= 64 || bid >= 64) {
        for (int it = rid; it < NDB * NH; it += nrest) { const int b = it >> 3, h = it & 7; scan_item(p, lds, MPR + b * DSEQ, DSEQ, MTOK + b, h, p.state_wkv + (size_t)it * 4096, p.out + OFF_WKVS + (size_t)it * 4096); }
    }
    conv_items(p);
}

struct EpiResid {
    static constexpr bool PERM = false, AFTER_DRAIN = false;
    const float* xp; const float* xs; float* out; float* ss;
    __device__ __forceinline__ void operator()(const f32x4 (&acc)[2][2][4][2], const pg8::Unit& u, int wr, int wc, int fr, int fq) const {
        const int row0 = u.pm * 256 + wr * 64 + fr, col0 = u.pn * 256 + wc * 32 + 4 * fq;
#pragma unroll
        for (int ai = 0; ai < 2; ++ai)
#pragma unroll
            for (int m = 0; m < 4; ++m) {
                const int row = row0 + ai * 128 + m * 16;
                const float* xr = (row < MPR ? xp + (size_t)row * D : xs + (size_t)(row - MPR) * D) + col0; float* orow = out + (size_t)row * D + col0; float s = 0.f;
#pragma unroll
                for (int bj = 0; bj < 2; ++bj)
#pragma unroll
                    for (int n = 0; n < 2; ++n) { const f32x4 hv = *(const f32x4*)(xr + bj * 128 + n * 16) + acc[ai][bj][m][n]; *(f32x4*)(orow + bj * 128 + n * 16) = hv; s += hv[0] * hv[0] + hv[1] * hv[1] + hv[2] * hv[2] + hv[3] * hv[3]; }
                s += __shfl_xor(s, 16); s += __shfl_xor(s, 32);
                if (fq == 0) atomicAdd(ss + row, s);
            }
    }
};

__device__ void phase4(const Params& p) {
    const float* SS = (const float*)(p.ws + WS_SS);
    for (size_t i = (size_t)blockIdx.x * 512 + threadIdx.x; i < (size_t)MTOK * 256; i += (size_t)gridDim.x * 512) {
        const int row = (int)(i >> 8), c = (int)(i & 255) * 4;
        const float rs = rsqrtf(SS[row] * (1.0f / 1024.0f) + 1e-6f);
        f32x4 v = *(f32x4*)(p.out + i * 4); const f32x4 g = *(const f32x4*)(p.final_g + c);
        *(f32x4*)(p.out + i * 4) = v * rs * g;
    }
}

__global__ void __launch_bounds__(512, 2) fwd_megakernel(Params p) {
    extern __shared__ __attribute__((aligned(16))) unsigned char lds[];
    cg::grid_group grid = cg::this_grid();
    phase0(p, lds);
    grid.sync();
    { pg8::Gemm g; g.A = (const bf16_t*)(p.ws + WS_XN); g.Bt = (const bf16_t*)(p.ws + WS_W1); g.M = MROWS; g.N = NP; g.K = D;
      pg8::StaticOrder S; S.init(g.M, g.N, (int)gridDim.x, (int)blockIdx.x);
      pg8::EpiBf16<0> E; E.O = (bf16_t*)(p.ws + WS_P); E.ldc = NP; E.bias = nullptr; E.split_cols = 0; E.split_stride = 0;
      pg8::gemm_phase<pg8::EpiBf16<0>, pg8::StaticOrder, false>((PG8_LAS unsigned char*)lds, g, S, E, nullptr); }
    grid.sync();
    phase2(p, lds);
    grid.sync();
    { pg8::Gemm g; g.A = (const bf16_t*)(p.ws + WS_YC); g.Bt = (const bf16_t*)(p.ws + WS_W2); g.M = MTOK; g.N = D; g.K = D;
      pg8::StaticOrder S; S.init(g.M, g.N, (int)gridDim.x, (int)blockIdx.x);
      EpiResid E; E.xp = p.x_prompt; E.xs = p.x_sample; E.out = p.out; E.ss = (float*)(p.ws + WS_SS);
      pg8::gemm_phase<EpiResid, pg8::StaticOrder, false>((PG8_LAS unsigned char*)lds, g, S, E, nullptr); }
    grid.sync();
    phase4(p);
}

extern "C" void kernel_launch(void* const* d_in, const int* in_sizes, int n_in, void* d_out, int out_size, void* d_ws, size_t ws_size, hipStream_t stream) {
    static int grid_blocks = 0;
    if (!grid_blocks) {
        int dev = 0, cus = 0, per_cu = 0;
        hipGetDevice(&dev); hipDeviceGetAttribute(&cus, hipDeviceAttributeMultiprocessorCount, dev);
        hipFuncSetAttribute((const void*)fwd_megakernel, hipFuncAttributeMaxDynamicSharedMemorySize, LDS_BYTES);
        hipOccupancyMaxActiveBlocksPerMultiprocessor(&per_cu, (const void*)fwd_megakernel, 512, LDS_BYTES);
        if (per_cu < 1) per_cu = 1;
        grid_blocks = cus * per_cu;
        if (ws_size < WS_END || n_in != 20) fprintf(stderr, "kernel_launch: unexpected sizes ws %zu n_in %d\n", ws_size, n_in);
    }
    Params p{};
    const float** pp = (const float**)&p;
    for (int i = 0; i < 20; ++i) pp[i] = (const float*)d_in[i];
    p.out = (float*)d_out; p.ws = (unsigned char*)d_ws;
    void* args[] = {&p};
    hipError_t e = hipLaunchCooperativeKernel((const void*)fwd_megakernel, dim3(grid_blocks), dim3(512), args, LDS_BYTES, stream);
    if (e != hipSuccess) fprintf(stderr, "cooperative launch failed: %s (grid %d)\n", hipGetErrorString(e), grid_blocks);
}
```

```cpp
#include <hip/hip_runtime.h>
#include <hip/hip_cooperative_groups.h>
#include <cstdio>
namespace cg = cooperative_groups;
namespace pg8 {
#define PG8_LAS __attribute__((address_space(3)))
typedef unsigned short bf16_t;
typedef short bf16x8 __attribute__((ext_vector_type(8)));
typedef float f32x4 __attribute__((ext_vector_type(4)));
typedef unsigned u32x4 __attribute__((ext_vector_type(4)));
constexpr int BM = 256, BK = 64, HALF = 128, HTB = HALF * BK * 2  , STAGE_BYTES = 8 * HTB, NXCD = 8, WGM = 8;

__host__ __device__ __forceinline__ int lds_byte(int r, int c) { const int st = (r >> 4) * 2 + (c >> 5), rr = r & 15, cc = c & 31, ob = rr * 64 + cc * 2; return st * 1024 + (ob ^ (((ob >> 9) & 1) << 5)); }
__host__ __device__ __forceinline__ void stage_rc(int b, int& R, int& C) { const int st = b / 1024, sb = b % 1024, swz = sb ^ (((sb >> 9) & 1) << 5); R = (st >> 1) * 16 + swz / 64; C = (st & 1) * 32 + (swz % 64) / 2; }
__host__ __device__ __forceinline__ int perm32(int rho) { const int n = rho >> 4, i = rho & 15; return 8 * (i >> 2) + 4 * n + (i & 3); }

struct Unit { int pm, pn; };
struct Gemm { const bf16_t* A; const bf16_t* Bt; int M, N, K; };

struct StaticOrder {
    int nM, nN, nwg, G, c;
    __host__ __device__ void init(int M, int N, int G_, int c_) { nM = M / BM; nN = N / BM; nwg = nM * nN; G = G_; c = c_; }
    __host__ __device__ bool next(int i, Unit& u) const {
        const long L = (long)i * G + c; if (L >= nwg) return false;
        int wgid = (int)L; { const int q = nwg / NXCD, r = nwg % NXCD, xcd = wgid % NXCD, off = wgid / NXCD; wgid = (xcd < r ? xcd * (q + 1) : r * (q + 1) + (xcd - r) * q) + off; }
        const int nig = WGM * nN, gid = wgid / nig, fm = gid * WGM, gsz = (nM - fm) < WGM ? (nM - fm) : WGM;
        u.pm = fm + ((wgid % nig) % gsz); u.pn = (wgid % nig) / gsz; return true;
    }
    __device__ __forceinline__ void a_ready(const Unit&) const {}
    __device__ __forceinline__ void done(const Unit&) const {}
};
struct CountedOrder : StaticOrder {
    const unsigned* ready; unsigned need; unsigned* tmo;
    __device__ __forceinline__ void a_ready(const Unit& u) const {
        if (threadIdx.x < 64) {
            const unsigned long long t0 = __builtin_amdgcn_s_memrealtime(); unsigned polls = 0;
            while ((unsigned)__builtin_amdgcn_readfirstlane(__hip_atomic_load(ready + 64 * u.pm, __ATOMIC_RELAXED, __HIP_MEMORY_SCOPE_AGENT)) < need) {
                if ((++polls & 255u) == 0u && __builtin_amdgcn_readfirstlane(__hip_atomic_load(tmo, __ATOMIC_RELAXED, __HIP_MEMORY_SCOPE_AGENT)) != 0u) break;
                if (__builtin_amdgcn_s_memrealtime() - t0 > 2000000ull) {
                    if (threadIdx.x == 0) { unsigned expect = 0u; __hip_atomic_compare_exchange_strong(tmo + 1, &expect, 0x600u | (unsigned)(u.pm & 0xff), __ATOMIC_RELAXED, __ATOMIC_RELAXED, __HIP_MEMORY_SCOPE_AGENT); __hip_atomic_store(tmo, 1u, __ATOMIC_RELAXED, __HIP_MEMORY_SCOPE_AGENT); }
                    break; }
                __builtin_amdgcn_s_sleep(2); }
            __builtin_amdgcn_fence(__ATOMIC_ACQUIRE, "agent");
            asm volatile("s_waitcnt vmcnt(0)" ::: "memory");
        }
#if !defined(BROKEN_HOOK_NO_BARRIER)
        asm volatile("" ::: "memory"); __builtin_amdgcn_s_barrier(); asm volatile("" ::: "memory");
#endif
    }
};

__device__ __forceinline__ unsigned cvt_pk_bf16(float lo, float hi) { unsigned r; asm volatile("v_cvt_pk_bf16_f32 %0, %1, %2" : "=v"(r) : "v"(lo), "v"(hi)); return r; }
typedef float f32x2 __attribute__((ext_vector_type(2)));
__device__ __forceinline__ f32x2 gelu_pk(f32x2 v) {
    const f32x2 av = __builtin_elementwise_abs(v), d = av * 0.2316418882f + 1.0f;
    f32x2 t; t.x = __builtin_amdgcn_rcpf(d.x); t.y = __builtin_amdgcn_rcpf(d.y);
    f32x2 q = t * 0.5307027145f + (-0.7265760135f); q = q * t + 0.7107068705f; q = q * t + (-0.142248368f); q = q * t + 0.127414796f; q = q * t;
    const f32x2 s = (v * v) * (-0.72134752044f);
    f32x2 e; e.x = __builtin_amdgcn_exp2f(s.x); e.y = __builtin_amdgcn_exp2f(s.y);
    const f32x2 m = v * (q * e), r = v - m;
    f32x2 o; o.x = v.x < 0.f ? m.x : r.x; o.y = v.y < 0.f ? m.y : r.y; return o;
}

struct EpiF32 {
    static constexpr bool PERM = false, AFTER_DRAIN = false;
    float* C; int ldc; const float* bias;
    __device__ __forceinline__ void operator()(const f32x4 (&acc)[2][2][4][2], const Unit& u, int wr, int wc, int fr, int fq) const {
        const int row0 = u.pm * BM + wr * 64 + fr, col0 = u.pn * BM + wc * 32 + 4 * fq;
        f32x4 bv[2][2];
#pragma unroll
        for (int bj = 0; bj < 2; ++bj)
#pragma unroll
            for (int n = 0; n < 2; ++n) bv[bj][n] = bias ? *(const f32x4*)(bias + col0 + bj * HALF + n * 16) : (f32x4){0.f, 0.f, 0.f, 0.f};
#pragma unroll
        for (int ai = 0; ai < 2; ++ai)
#pragma unroll
            for (int m = 0; m < 4; ++m) { float* rowp = C + (size_t)(row0 + ai * HALF + m * 16) * ldc + col0;
#pragma unroll
                for (int bj = 0; bj < 2; ++bj)
#pragma unroll
                    for (int n = 0; n < 2; ++n) *(f32x4*)(rowp + bj * HALF + n * 16) = acc[ai][bj][m][n] + bv[bj][n]; }
    }
};
template <int ACT  > struct EpiBf16 {
    static constexpr bool PERM = true, AFTER_DRAIN = false;
    bf16_t* O; int ldc; const float* bias; int split_cols; size_t split_stride;
    __device__ __forceinline__ void operator()(const f32x4 (&acc)[2][2][4][2], const Unit& u, int wr, int wc, int fr, int fq) const {
        const int row0 = u.pm * BM + wr * 64 + fr; int colt = u.pn * BM; bf16_t* base = O;
        if (split_cols) { const int t = colt / split_cols; base += (size_t)t * split_stride; colt -= t * split_cols; }
        const int col0 = colt + wc * 32 + 8 * fq, bcol0 = u.pn * BM + wc * 32 + 8 * fq;
        f32x4 bv[2][2];
#pragma unroll
        for (int bj = 0; bj < 2; ++bj)
#pragma unroll
            for (int n = 0; n < 2; ++n) bv[bj][n] = bias ? *(const f32x4*)(bias + bcol0 + bj * HALF + 4 * n) : (f32x4){0.f, 0.f, 0.f, 0.f};
#pragma unroll
        for (int ai = 0; ai < 2; ++ai)
#pragma unroll
            for (int m = 0; m < 4; ++m) { bf16_t* rowp = base + (size_t)(row0 + ai * HALF + m * 16) * ldc + col0;
#pragma unroll
                for (int bj = 0; bj < 2; ++bj) { f32x4 v0 = acc[ai][bj][m][0] + bv[bj][0], v1 = acc[ai][bj][m][1] + bv[bj][1];
                    if (ACT == 1) { f32x2 a = gelu_pk((f32x2){v0[0], v0[1]}), b = gelu_pk((f32x2){v0[2], v0[3]}), c = gelu_pk((f32x2){v1[0], v1[1]}), d = gelu_pk((f32x2){v1[2], v1[3]});
                        v0 = (f32x4){a.x, a.y, b.x, b.y}; v1 = (f32x4){c.x, c.y, d.x, d.y}; }
                    if (ACT == 2) {
#pragma unroll
                        for (int j = 0; j < 4; ++j) { v0[j] = 0.5f * v0[j] * (1.0f + erff(v0[j] * 0.70710678f)); v1[j] = 0.5f * v1[j] * (1.0f + erff(v1[j] * 0.70710678f)); } }
                    u32x4 w; w.x = cvt_pk_bf16(v0[0], v0[1]); w.y = cvt_pk_bf16(v0[2], v0[3]); w.z = cvt_pk_bf16(v1[0], v1[1]); w.w = cvt_pk_bf16(v1[2], v1[3]);
                    *(u32x4*)(rowp + bj * HALF) = w; } }
    }
};
template <class Epi, class Sched, bool STAMP = false>
__device__ __forceinline__ void gemm_phase(PG8_LAS unsigned char* lds, const Gemm g, const Sched& S, const Epi& E, unsigned long long* stamps) {
    int tid_ = threadIdx.x; asm volatile("" : "+v"(tid_));
    const int tid = tid_, wid = __builtin_amdgcn_readfirstlane(tid >> 6), lane = tid & 63, wr = wid >> 2, wc = wid & 3, fr = lane & 15, fq = lane >> 4;
    const int K = g.K, nt = K / BK;
    int ts_lo = 0, ts_hi = 0, nts = 0; const unsigned long long rt_entry = STAMP ? (unsigned long long)wall_clock64() : 0ull;
#define PG8_STAMP() do { if (STAMP && wid == 0 && nts < 64) { const unsigned long long _c = (unsigned long long)clock64(); \
        ts_lo = (lane == nts) ? (int)(unsigned)_c : ts_lo; ts_hi = (lane == nts) ? (int)(unsigned)(_c >> 32) : ts_hi; ++nts; } } while (0)
    PG8_STAMP();
    unsigned voffA[2], voffB[2];
#pragma unroll
    for (int i = 0; i < 2; ++i) { int R, C; stage_rc(tid * 16 + i * 8192, R, C); const int Rb = Epi::PERM ? ((R & ~31) + perm32(R & 31)) : R;
        voffA[i] = (unsigned)(R * K + C) * 2u; voffB[i] = (unsigned)(Rb * K + C) * 2u; }
    const size_t kstep = (size_t)(BK * 2);
    const size_t hstep = (size_t)HALF * K * 2;
    const size_t tstep = 2 * hstep;
    const unsigned ldsw = (unsigned)wid * 1024u;
    const int aoff = lds_byte(wr * 64 + fr, fq * 8), boff = lds_byte(wc * 32 + fr, fq * 8);
#define PG8_SA(b, h) (((b) * 2 + (h)) * HTB)
#define PG8_SB(b, h) ((4 + (b) * 2 + (h)) * HTB)
#define PG8_STAGE(bufoff, gbase, voff) do { _Pragma("unroll") for (int _i = 0; _i < 2; ++_i) \
        __builtin_amdgcn_global_load_lds((const unsigned*)((const char*)(gbase) + (voff)[_i]), (PG8_LAS unsigned*)(lds + (bufoff) + ldsw + _i * 8192), 16, 0, 0); } while (0)
#define PG8_LDA(dst, b, h) do { _Pragma("unroll") for (int m = 0; m < 4; ++m) _Pragma("unroll") for (int k = 0; k < 2; ++k) dst[m][k] = *(const PG8_LAS bf16x8*)(lds + PG8_SA(b, h) + aoff + m * 2048 + k * 1024); } while (0)
#define PG8_LDB(dst, b, h) do { _Pragma("unroll") for (int n = 0; n < 2; ++n) _Pragma("unroll") for (int k = 0; k < 2; ++k) dst[n][k] = *(const PG8_LAS bf16x8*)(lds + PG8_SB(b, h) + boff + n * 2048 + k * 1024); } while (0)
#define PG8_MMA(ai, bj, At, Bt) do { __builtin_amdgcn_s_setprio(1); _Pragma("unroll") for (int m = 0; m < 4; ++m) _Pragma("unroll") for (int n = 0; n < 2; ++n) _Pragma("unroll") for (int k = 0; k < 2; ++k) \
        acc[ai][bj][m][n] = __builtin_amdgcn_mfma_f32_16x16x32_bf16(Bt[n][k], At[m][k], acc[ai][bj][m][n], 0, 0, 0); __builtin_amdgcn_s_setprio(0); } while (0)
#define PG8_WAIT_V(n) asm volatile("s_waitcnt vmcnt(" #n ")" ::: "memory")
#define PG8_WAIT_L(n) asm volatile("s_waitcnt lgkmcnt(" #n ")" ::: "memory")
#define PG8_BAR __builtin_amdgcn_s_barrier()
#define PG8_SCHED __builtin_amdgcn_sched_barrier(0)
    Unit cur, nxt; int ui = 0;
    if (!S.next(0, cur)) return;
    f32x4 acc[2][2][4][2];
#pragma unroll
    for (int a = 0; a < 2; ++a)
#pragma unroll
        for (int b = 0; b < 2; ++b)
#pragma unroll
            for (int m = 0; m < 4; ++m)
#pragma unroll
                for (int n = 0; n < 2; ++n) acc[a][b][m][n] = (f32x4){0.f, 0.f, 0.f, 0.f};
    bf16x8 At[4][2], B0[2][2], B1[2][2];
    const char* cA = (const char*)g.A + (size_t)cur.pm * tstep; const char* cB = (const char*)g.Bt + (size_t)cur.pn * tstep;
    S.a_ready(cur);
    PG8_STAGE(PG8_SB(0, 0), cB, voffB); PG8_STAGE(PG8_SA(0, 0), cA, voffA); PG8_STAGE(PG8_SB(0, 1), cB + hstep, voffB); PG8_STAGE(PG8_SA(0, 1), cA + hstep, voffA);
    if (wr == 1) PG8_BAR;
    PG8_WAIT_V(4); PG8_BAR;
    PG8_STAGE(PG8_SB(1, 0), cB + kstep, voffB); PG8_STAGE(PG8_SA(1, 0), cA + kstep, voffA); PG8_STAGE(PG8_SB(1, 1), cB + hstep + kstep, voffB);
    PG8_WAIT_V(6); PG8_BAR;
    PG8_STAMP();
    for (;;) {
        const bool has_next = S.next(ui + 1, nxt);
        const char* nA = has_next ? (const char*)g.A + (size_t)nxt.pm * tstep : cA; const char* nB = has_next ? (const char*)g.Bt + (size_t)nxt.pn * tstep : cB;
        for (int t = 0; t < nt; t += 2) {
            const bool last = (t == nt - 2);
            const char* a1 = cA + (size_t)(t + 1) * kstep;
            const char* a2 = last ? nA : cA + (size_t)(t + 2) * kstep; const char* b2 = last ? nB : cB + (size_t)(t + 2) * kstep;
            const char* a3 = a2 + kstep; const char* b3 = b2 + kstep;
            if (last && has_next) S.a_ready(nxt);
            PG8_LDB(B0, 0, 0); PG8_SCHED; PG8_LDA(At, 0, 0); PG8_STAGE(PG8_SA(1, 1), a1 + hstep, voffA);
            PG8_WAIT_L(8); PG8_BAR; PG8_WAIT_L(0); PG8_MMA(0, 0, At, B0); PG8_BAR; PG8_SCHED;
            PG8_LDB(B1, 0, 1); PG8_STAGE(PG8_SB(0, 0), b2, voffB);
            PG8_BAR; PG8_WAIT_L(0); PG8_MMA(0, 1, At, B1); PG8_BAR;
            PG8_LDA(At, 0, 1); PG8_STAGE(PG8_SA(0, 0), a2, voffA);
            PG8_BAR; PG8_WAIT_L(0); PG8_MMA(1, 0, At, B0); PG8_BAR; PG8_SCHED;
            PG8_STAGE(PG8_SB(0, 1), b2 + hstep, voffB);
            PG8_WAIT_V(6); PG8_BAR; PG8_MMA(1, 1, At, B1); PG8_BAR;
            PG8_LDB(B0, 1, 0); PG8_SCHED; PG8_LDA(At, 1, 0); PG8_STAGE(PG8_SA(0, 1), a2 + hstep, voffA);
            PG8_WAIT_L(8); PG8_BAR; PG8_WAIT_L(0); PG8_MMA(0, 0, At, B0); PG8_BAR; PG8_SCHED;
            PG8_LDB(B1, 1, 1); PG8_STAGE(PG8_SB(1, 0), b3, voffB);
            PG8_BAR; PG8_WAIT_L(0); PG8_MMA(0, 1, At, B1); PG8_BAR;
            PG8_LDA(At, 1, 1); PG8_STAGE(PG8_SA(1, 0), a3, voffA);
            PG8_BAR; PG8_WAIT_L(0); PG8_MMA(1, 0, At, B0); PG8_BAR; PG8_SCHED;
            PG8_STAGE(PG8_SB(1, 1), b3 + hstep, voffB);
            PG8_WAIT_V(6); PG8_BAR; PG8_MMA(1, 1, At, B1); PG8_BAR;
        }
        PG8_STAMP();
        if constexpr (!Epi::AFTER_DRAIN) { E(acc, cur, wr, wc, fr, fq); S.done(cur); }
        PG8_STAMP();
        if (!has_next) break;
#pragma unroll
        for (int a = 0; a < 2; ++a)
#pragma unroll
            for (int b = 0; b < 2; ++b)
#pragma unroll
                for (int m = 0; m < 4; ++m)
#pragma unroll
                    for (int n = 0; n < 2; ++n) acc[a][b][m][n] = (f32x4){0.f, 0.f, 0.f, 0.f};
        cur = nxt; cA = nA; cB = nB; ++ui;
    }
    PG8_WAIT_V(0);
    if (wr == 0) PG8_BAR;
    PG8_BAR;
    if constexpr (Epi::AFTER_DRAIN) { E.fused(acc, cur, wr, wc, fr, fq, lds, wid, lane); S.done(cur); }
    PG8_STAMP();
    if (STAMP && wid == 0) { stamps[lane] = lane < nts ? (((unsigned long long)(unsigned)ts_hi << 32) | (unsigned)ts_lo) : 0ull;
        if (lane == 62) stamps[62] = rt_entry; if (lane == 63) stamps[63] = (unsigned long long)wall_clock64(); }
#undef PG8_STAMP
#undef PG8_SA
#undef PG8_SB
#undef PG8_STAGE
#undef PG8_LDA
#undef PG8_LDB
#undef PG8_MMA
#undef PG8_WAIT_V
#undef PG8_WAIT_L
#undef PG8_BAR
#undef PG8_SCHED
}
}
using pg8::bf16_t; using pg8::f32x4;
typedef __bf16 bf16x2_n __attribute__((ext_vector_type(2))); typedef float f32x2_n __attribute__((ext_vector_type(2)));
__device__ __forceinline__ unsigned cvt_pk_bf16(float lo, float hi) { const f32x2_n v = {lo, hi}; return __builtin_bit_cast(unsigned, __builtin_convertvector(v, bf16x2_n)); }
typedef unsigned u32x2 __attribute__((ext_vector_type(2)));
typedef unsigned u32x4v __attribute__((ext_vector_type(4)));
constexpr int D = 1024, MPR = 16384, MTOK = 17408, MROWS = 17664, INC = 4224, NP = 4352, SEQ = 2048, DSEQ = 8, NDB = 128, NH = 8;
constexpr int RC = 2048;
constexpr size_t OFF_YS = (size_t)MPR * D, OFF_CONVP = OFF_YS + 1024 * 1024, OFF_SHIFTP = OFF_CONVP + 8192, OFF_WKVP = OFF_SHIFTP + 8192,
                 OFF_CONVS = OFF_WKVP + 262144, OFF_SHIFTS = OFF_CONVS + 131072, OFF_WKVS = OFF_SHIFTS + 131072;
constexpr size_t WS_XN = 0, WS_W1 = WS_XN + (size_t)MROWS * D * 2, WS_W2 = WS_W1 + (size_t)NP * D * 2, WS_P = WS_W2 + (size_t)D * D * 2,
                 WS_YC = WS_P + (size_t)MROWS * NP * 2, WS_SS = WS_YC + (size_t)MTOK * D * 2, WS_BAR = WS_SS + (size_t)MTOK * 4, WS_CHC = WS_BAR + 16384, WS_RHO = WS_BAR + 65536, WS_MN = WS_RHO + (size_t)MPR * 512 * 2, WS_BON = WS_MN + (size_t)256 * 2 * 4096 * 4, WS_END = WS_BON + (size_t)MPR * 8 * 4;
constexpr size_t WS_OZ = WS_XN;
static_assert((size_t)MPR * 512 * 4 <= (size_t)MROWS * D * 2 && WS_END <= 268435456, "workspace map");
constexpr int LDS_BYTES = 153872;

struct Params {
    const float *x_prompt, *x_sample, *state_conv, *state_shift, *state_wkv, *norm_g, *w_in, *mu_shift, *conv_w, *w_dec2, *w0, *w_a2, *a0, *k_k, *k_a, *r_k, *lnx_g, *lnx_b, *w_out, *final_g;
    float* out; unsigned char* ws;
    int use_cg_sync, pad_;
};

__device__ __forceinline__ float bf2f(unsigned short b) { return __uint_as_float(((unsigned)b) << 16); }
__device__ __forceinline__ float bflo(unsigned w) { return __uint_as_float(w << 16); }
__device__ __forceinline__ float bfhi(unsigned w) { return __uint_as_float(w & 0xffff0000u); }
__device__ __forceinline__ float sigmoidf_(float x) { return __builtin_amdgcn_rcpf(1.0f + __expf(-x)); }
__device__ __forceinline__ float siluf_(float x) { return x * __builtin_amdgcn_rcpf(1.0f + __expf(-x)); }

#define XB_TMO      128
#define XB_XCNT(j)  (256  + 64 * (j))
#define XB_XSUB(j)  (1280 + 64 * (j))
#define XB_XGEN(j)  (2304 + 64 * (j))
#define XB_TOP      3328
#define XB_TOPGEN   3392
#define XCD_BAR_WORDS 3456
#define XB_SPIN_CAP (1u << 18)
#define LAS __attribute__((address_space(3)))

__device__ __forceinline__ unsigned xb_ld(unsigned* p)              { return __hip_atomic_load(p, __ATOMIC_RELAXED, __HIP_MEMORY_SCOPE_AGENT); }
__device__ __forceinline__ unsigned xb_add(unsigned* p, unsigned v) { return __hip_atomic_fetch_add(p, v, __ATOMIC_RELAXED, __HIP_MEMORY_SCOPE_AGENT); }
__device__ __forceinline__ unsigned xb_xcc_id() { return (unsigned)__builtin_amdgcn_s_getreg((3 << 11) | 20) & 0xFu; }
#define XB_SPIN(cond, bar) do { unsigned _sp = 0; while (cond) { __builtin_amdgcn_s_sleep(1); \
    if ((++_sp & 255u) == 0u) { if (xb_ld(&(bar)[XB_TMO])) break; if (_sp > XB_SPIN_CAP) { atomicAdd(&(bar)[XB_TMO], 1u); break; } } } } while (0)

struct XcdBarrier {
    unsigned* bar; unsigned x;
    volatile LAS unsigned* st;
};

__device__ __forceinline__ XcdBarrier xcd_barrier_post(unsigned* bar, volatile LAS unsigned* st) {
    XcdBarrier b; b.bar = bar; b.x = xb_xcc_id(); b.st = st;
    if (threadIdx.x == 0) (void)xb_add(&bar[XB_XCNT(b.x)], 1u);
    return b;
}
__device__ __forceinline__ void xcd_barrier_complete(unsigned* bar, unsigned x, unsigned& nloc, unsigned& nx) {
    const unsigned G = gridDim.x * gridDim.y * gridDim.z;
    unsigned sum, cnt, mine, sp = 0u;
    for (;;) {
        sum = 0u; cnt = 0u; mine = 0u;
#pragma unroll
        for (unsigned j = 0; j < 16; ++j) { const unsigned c = xb_ld(&bar[XB_XCNT(j)]); sum += c; cnt += (c > 0u) ? 1u : 0u; mine = (j == x) ? c : mine; }
        if (sum == G) break;
        __builtin_amdgcn_s_sleep(1);
        if ((++sp & 255u) == 0u) { if (xb_ld(&bar[XB_TMO])) break; if (sp > XB_SPIN_CAP) { atomicAdd(&bar[XB_TMO], 1u); break; } }
    }
    nloc = mine > 0u ? mine : 1u; nx = cnt > 0u ? cnt : 1u;
}

__device__ __forceinline__ void xcd_barrier(const XcdBarrier& b) {
    asm volatile("s_waitcnt vmcnt(0)" ::: "memory");
    __syncthreads();
    if (threadIdx.x == 0) {
        unsigned* bar = b.bar;
        __builtin_amdgcn_s_waitcnt(0);
        unsigned nloc = b.st[0], nx = b.st[1];
        if (nloc == 0u) { xcd_barrier_complete(bar, b.x, nloc, nx); b.st[0] = nloc; b.st[1] = nx; }
        const unsigned old = xb_add(&bar[XB_XSUB(b.x)], 1u);
        const unsigned gen = old / nloc;
        if (old + 1u == (gen + 1u) * nloc) {
            __builtin_amdgcn_fence(__ATOMIC_RELEASE, "agent");
            asm volatile("s_waitcnt vmcnt(0)" ::: "memory");
            const unsigned og = xb_add(&bar[XB_TOP], 1u);
            const unsigned tg = og / nx;
            if (og + 1u == (tg + 1u) * nx) xb_add(&bar[XB_TOPGEN], 1u);
            else XB_SPIN(xb_ld(&bar[XB_TOPGEN]) == tg, bar);
            __builtin_amdgcn_fence(__ATOMIC_ACQUIRE, "agent");
            xb_add(&bar[XB_XGEN(b.x)], 1u);
            asm volatile("s_waitcnt vmcnt(0)" ::: "memory");
        } else {
            XB_SPIN(xb_ld(&bar[XB_XGEN(b.x)]) == gen, bar);
            __builtin_amdgcn_fence(__ATOMIC_ACQUIRE, "agent");
            asm volatile("s_waitcnt vmcnt(0)" ::: "memory");
        }
    }
    __syncthreads();
}

struct EpiP {
    static constexpr bool PERM = true, AFTER_DRAIN = false;
    bf16_t* P;
    __device__ __forceinline__ void operator()(const f32x4 (&acc)[2][2][4][2], const pg8::Unit& u, int wr, int wc, int fr, int fq) const {
        const int row0 = u.pm * 256 + wr * 64 + fr;
        if (u.pn < 8) {
            const int ch0 = 64 * u.pn + 16 * wc + 4 * fq;
#pragma unroll
            for (int ai = 0; ai < 2; ++ai)
#pragma unroll
                for (int m = 0; m < 4; ++m) { bf16_t* rowp = P + (size_t)(row0 + ai * 128 + m * 16) * NP + ch0;
                    const f32x4 hh = acc[ai][0][m][0], cc = acc[ai][0][m][1], bb = acc[ai][1][m][0], gg = acc[ai][1][m][1];
                    const f32x4 uu = cc * hh; f32x4 qq;
#pragma unroll
                    for (int e = 0; e < 4; ++e) qq[e] = bb[e] * gg[e] * __builtin_amdgcn_rcpf(1.0f + __expf(-gg[e]));
                    u32x2 w0; w0.x = cvt_pk_bf16(uu[0], uu[1]); w0.y = cvt_pk_bf16(uu[2], uu[3]); u32x2 w1; w1.x = cvt_pk_bf16(qq[0], qq[1]); w1.y = cvt_pk_bf16(qq[2], qq[3]);
                    *(u32x2*)rowp = w0; *(u32x2*)(rowp + 512) = w1; }
        } else {
            const int col0 = u.pn * 256 + wc * 32 + 8 * fq;
#pragma unroll
            for (int ai = 0; ai < 2; ++ai)
#pragma unroll
                for (int m = 0; m < 4; ++m) { bf16_t* rowp = P + (size_t)(row0 + ai * 128 + m * 16) * NP + col0;
#pragma unroll
                    for (int bj = 0; bj < 2; ++bj) { const f32x4 v0 = acc[ai][bj][m][0], v1 = acc[ai][bj][m][1];
                        u32x4v w; w.x = cvt_pk_bf16(v0[0], v0[1]); w.y = cvt_pk_bf16(v0[2], v0[3]); w.z = cvt_pk_bf16(v1[0], v1[1]); w.w = cvt_pk_bf16(v1[2], v1[3]);
                        *(u32x4v*)(rowp + bj * 128) = w; } }
        }
    }
};
__device__ void phase0(const Params& p, unsigned char* lds) {
    int tid_ = threadIdx.x; asm volatile("" : "+v"(tid_)); const int tid = tid_, nb = gridDim.x, bid = blockIdx.x, wid = tid >> 6, lane = tid & 63;
    float* tile = (float*)lds;
    bf16_t* W1 = (bf16_t*)(p.ws + WS_W1); bf16_t* W2 = (bf16_t*)(p.ws + WS_W2); bf16_t* XN = (bf16_t*)(p.ws + WS_XN); float* SS = (float*)(p.ws + WS_SS);
    for (int it0 = bid; it0 < 1088 + 256; it0 += 2 * nb) {
        float vals[2][8];
#pragma unroll
        for (int u = 0; u < 2; ++u) { const int it = it0 + u * nb;
            if (it < 1088 + 256) { const float* src; int ncs, n0, k0;
                if (it < 1088) { const int kt = it / 68, nt = it % 68; src = p.w_in; ncs = INC; n0 = nt * 64; k0 = kt * 64; }
                else { const int j = it - 1088, kt = j >> 4, nt = j & 15; src = p.w_out; ncs = D; n0 = nt * 64; k0 = kt * 64; }
#pragma unroll
                for (int e = 0; e < 8; ++e) { const int idx = e * 512 + tid, kk = idx >> 6, nn = idx & 63, n = n0 + nn; vals[u][e] = (n < ncs) ? src[(size_t)(k0 + kk) * ncs + n] : 0.f; } } }
#pragma unroll
        for (int u = 0; u < 2; ++u)
#pragma unroll
            for (int e = 0; e < 8; ++e) { const int idx = e * 512 + tid, kk = idx >> 6, nn = idx & 63; tile[u * 4160 + kk * 65 + nn] = vals[u][e]; }
        __syncthreads();
#pragma unroll
        for (int u = 0; u < 2; ++u) { const int it = it0 + u * nb;
            if (it < 1088 + 256) { bf16_t* dst; int n0, k0;
                bool cperm = false;
                if (it < 1088) { const int kt = it / 68, nt = it % 68; dst = W1; n0 = nt * 64; k0 = kt * 64; cperm = n0 < 2048; }
                else { const int j = it - 1088, kt = j >> 4, nt = j & 15; dst = W2; n0 = nt * 64; k0 = kt * 64; }
                const int ty = n0 >> 9, cbase = 256 * ((n0 & 511) >> 6) + 128 * (ty & 1) + 4 * (ty >> 1);
#pragma unroll
                for (int e = 0; e < 4; ++e) { const int idx = e * 512 + tid, nn = idx >> 5, kp = idx & 31; const int drow = cperm ? cbase + 32 * (nn >> 4) + 8 * ((nn >> 2) & 3) + (nn & 3) : n0 + nn;
                    *(unsigned*)(dst + (size_t)drow * D + k0 + 2 * kp) = cvt_pk_bf16(tile[u * 4160 + (2 * kp) * 65 + nn], tile[u * 4160 + (2 * kp + 1) * 65 + nn]); } } }
        __syncthreads();
    }
    for (int i = bid * 512 + tid; i < MTOK; i += nb * 512) SS[i] = 0.f;
    const int nw = nb * 8;
    for (int r0 = bid * 8 + wid; r0 < MROWS; r0 += 2 * nw) {
        f32x4 v[2][4];
#pragma unroll
        for (int j = 0; j < 2; ++j) { const int row = r0 + j * nw;
            if (row < MTOK + NDB) { const float* xr = row < MPR ? p.x_prompt + (size_t)row * D : (row < MTOK ? p.x_sample + (size_t)(row - MPR) * D : p.state_shift + (size_t)(row - MTOK) * D);
#pragma unroll
                for (int i = 0; i < 4; ++i) v[j][i] = __builtin_nontemporal_load((const f32x4*)(xr + (lane + 64 * i) * 4)); }
            else {
#pragma unroll
                for (int i = 0; i < 4; ++i) v[j][i] = (f32x4){0.f, 0.f, 0.f, 0.f}; } }
#pragma unroll
        for (int j = 0; j < 2; ++j) { const int row = r0 + j * nw; if (row < MROWS) {
            bf16_t* xo = XN + (size_t)row * D; float rs = 1.0f; float* sh = nullptr;
            if (row < MTOK) { float s = 0.f;
#pragma unroll
                for (int i = 0; i < 4; ++i) s += v[j][i][0] * v[j][i][0] + v[j][i][1] * v[j][i][1] + v[j][i][2] * v[j][i][2] + v[j][i][3] * v[j][i][3];
#pragma unroll
                for (int o = 32; o >= 1; o >>= 1) s += __shfl_xor(s, o);
                rs = rsqrtf(s * (1.0f / 1024.0f) + 1e-6f);
                if (row < MPR) { if ((row & (SEQ - 1)) == SEQ - 1) sh = p.out + OFF_SHIFTP + (size_t)(row >> 11) * D; }
                else { const int rs_ = row - MPR; if ((rs_ & 7) == 7) sh = p.out + OFF_SHIFTS + (size_t)(rs_ >> 3) * D; } }
#pragma unroll
            for (int i = 0; i < 4; ++i) { const int c = (lane + 64 * i) * 4; f32x4 y = v[j][i];
                if (row < MTOK) { const f32x4 g = *(const f32x4*)(p.norm_g + c); y = y * rs * g; }
                u32x2 w; w.x = cvt_pk_bf16(y[0], y[1]); w.y = cvt_pk_bf16(y[2], y[3]); *(u32x2*)(xo + c) = w; if (sh) *(f32x4*)(sh + c) = y; } } }
    }
}

__device__ __forceinline__ void ld8(const bf16_t* ptr, float (&f)[8]) { const u32x4v w = *(const u32x4v*)ptr; f[0] = bflo(w.x); f[1] = bfhi(w.x); f[2] = bflo(w.y); f[3] = bfhi(w.y); f[4] = bflo(w.z); f[5] = bfhi(w.z); f[6] = bflo(w.w); f[7] = bfhi(w.w); }
__device__ void conv_items(const Params& p, int first, int stride, int end, const int tidc, const int tgroups) {
    int tid_ = threadIdx.x; asm volatile("" : "+v"(tid_)); const int tid = tid_;
    const bf16_t* P = (const bf16_t*)(p.ws + WS_P); bf16_t* YC = (bf16_t*)(p.ws + WS_YC);
    const int c0 = (tidc & 63) * 8;
    float cw0[8], cw1[8], cw2[8];
#pragma unroll
    for (int j = 0; j < 8; ++j) { cw0[j] = p.conv_w[c0 + j]; cw1[j] = p.conv_w[512 + c0 + j]; cw2[j] = p.conv_w[1024 + c0 + j]; }
#pragma unroll 1
    for (int it = first; it < end; it += stride) {
        const int R0 = it * (4 * tgroups) + (tidc >> 6) * 4;
        int t0, T; const float* cbuf; float* cout;
        if (R0 < MPR) { const int b = R0 >> 11; t0 = R0 & (SEQ - 1); T = SEQ; cbuf = nullptr; cout = p.out + OFF_CONVP + (size_t)b * 1024; }
        else { const int rs = R0 - MPR, b = rs >> 3; t0 = rs & 7; T = DSEQ; cbuf = p.state_conv + (size_t)b * 1024; cout = p.out + OFF_CONVS + (size_t)b * 1024; }
        const bool inseq = t0 >= 2;
        const bf16_t* pr = P + (size_t)R0 * NP + c0; const bf16_t* pm = inseq ? pr - 2 * NP : pr;
        u32x4v wu[6], wq[4];
#pragma unroll
        for (int k = 0; k < 2; ++k) wu[k] = *(const u32x4v*)(pm + (size_t)k * NP);
#pragma unroll
        for (int k = 0; k < 4; ++k) { wu[2 + k] = *(const u32x4v*)(pr + (size_t)k * NP); wq[k] = *(const u32x4v*)(pr + (size_t)k * NP + 512); }
        float u[6][8];
#pragma unroll
        for (int k = 0; k < 6; ++k) { const unsigned uw[4] = {wu[k].x, wu[k].y, wu[k].z, wu[k].w};
#pragma unroll
            for (int j = 0; j < 4; ++j) { u[k][2 * j] = bflo(uw[j]); u[k][2 * j + 1] = bfhi(uw[j]); } }
        if (!inseq) {
#pragma unroll
            for (int j = 0; j < 8; ++j) { u[0][j] = cbuf ? cbuf[c0 + j] : 0.f; u[1][j] = cbuf ? cbuf[512 + c0 + j] : 0.f; } }
#pragma unroll
        for (int k = 0; k < 4; ++k) { const unsigned qw[4] = {wq[k].x, wq[k].y, wq[k].z, wq[k].w}; float y[8];
#pragma unroll
            for (int j = 0; j < 8; ++j) { const float qg = (j & 1) ? bfhi(qw[j >> 1]) : bflo(qw[j >> 1]);
                y[j] = qg * (cw0[j] * u[k][j] + cw1[j] * u[k + 1][j] + cw2[j] * u[k + 2][j]); }
            u32x4v w; w.x = cvt_pk_bf16(y[0], y[1]); w.y = cvt_pk_bf16(y[2], y[3]); w.z = cvt_pk_bf16(y[4], y[5]); w.w = cvt_pk_bf16(y[6], y[7]);
            *(u32x4v*)(YC + (size_t)(R0 + k) * D + c0) = w; }
        if (t0 + 4 == T) {
#pragma unroll
            for (int j = 0; j < 8; j += 4) { *(f32x4*)(cout + c0 + j) = (f32x4){u[4][j], u[4][j + 1], u[4][j + 2], u[4][j + 3]}; *(f32x4*)(cout + 512 + c0 + j) = (f32x4){u[5][j], u[5][j + 1], u[5][j + 2], u[5][j + 3]}; } }
    }
}

typedef short s16x4 __attribute__((ext_vector_type(4)));
typedef short s16x8 __attribute__((ext_vector_type(8)));
typedef unsigned short __attribute__((may_alias)) us_a; typedef float __attribute__((may_alias)) f32_a; typedef u32x2 __attribute__((may_alias)) u32x2_a;
typedef f32x4 __attribute__((may_alias)) f32x4_a; typedef u32x4v __attribute__((may_alias)) u32x4v_a; typedef s16x8 __attribute__((may_alias)) s16x8_a;
#define DI __device__ __forceinline__
DI u32x2 pk4(const f32x4 v) { u32x2 r; r.x = cvt_pk_bf16(v[0], v[1]); r.y = cvt_pk_bf16(v[2], v[3]); return r; }
DI s16x8 mk8(const u32x2 a, const u32x2 b) { u32x4v t; t.x = a.x; t.y = a.y; t.z = b.x; t.w = b.y; return __builtin_bit_cast(s16x8, t); }
DI s16x4 mk4(const u32x2 a) { return __builtin_bit_cast(s16x4, a); }
DI unsigned short bf1(float x) { return (unsigned short)(cvt_pk_bf16(x, 0.f) & 0xffffu); }
#define MFMA32(a, b, c) __builtin_amdgcn_mfma_f32_16x16x32_bf16((a), (b), (c), 0, 0, 0)
#define MFMA16(a, b, c) __builtin_amdgcn_mfma_f32_16x16x16bf16_1k((a), (b), (c), 0, 0, 0)
template <int CTRL> DI float dppf(float x) { return __int_as_float(__builtin_amdgcn_update_dpp(0, __float_as_int(x), CTRL, 0xf, 0xf, true)); }
template <int CTRL> DI unsigned dppu(unsigned x) { return (unsigned)__builtin_amdgcn_update_dpp(0, (int)x, CTRL, 0xf, 0xf, true); }
constexpr int SB_W = 0, SB_RT = 2304, SB_X0 = 4608, SB_AT = SB_X0 + 2048, SB_BK = 8704, SB_VT = 13312, SB_ARK = 15360, SB_GAM = 16512, SUBSZ = 16768;
constexpr int WROW = 144, BKROW = 72, ARKROW = 72;
struct SubIn { int row0, prevrow, nvalid, h; };

constexpr int LD_WD = 8 * SUBSZ, LD_WA = LD_WD + 8192, LD_PT = LD_WA + 8192, LD_XB = LD_PT + 13 * 256;
static_assert(LD_XB + 16 == LDS_BYTES, "LDS map");
DI void fill_lora(const float* w, int h, int wv, int lane, unsigned char* dst) {
    const int c = lane & 15, q = lane >> 4, mt = wv >> 1, ks = wv & 1; float f[8];
#pragma unroll
    for (int j = 0; j < 8; ++j) f[j] = w[(size_t)(16 * (2 * ks + (j >> 2)) + 4 * q + (j & 3)) * 512 + h * 64 + 16 * mt + c];
    u32x4v o; o.x = cvt_pk_bf16(f[0], f[1]); o.y = cvt_pk_bf16(f[2], f[3]); o.z = cvt_pk_bf16(f[4], f[5]); o.w = cvt_pk_bf16(f[6], f[7]);
    *(u32x4v_a*)(dst + (wv * 64 + lane) * 16) = o;
}
DI void fill_params(const Params& p, int h, unsigned char* lds) {
    for (int i = threadIdx.x; i < 13 * 64; i += 512) { const int row = i >> 6, j = i & 63, hj = h * 64 + j; float v;
        switch (row) { case 0: v = p.mu_shift[hj]; break; case 1: v = p.mu_shift[512 + hj]; break; case 2: v = p.mu_shift[1024 + hj]; break; case 3: v = p.mu_shift[1664 + hj]; break;
            case 4: v = p.mu_shift[1536 + j]; break; case 5: v = p.mu_shift[1600 + j]; break; case 6: v = p.w0[hj]; break; case 7: v = p.a0[hj]; break; case 8: v = p.k_k[hj]; break;
            case 9: v = p.k_a[hj]; break; case 10: v = p.r_k[hj]; break; case 11: v = p.lnx_g[hj]; break; default: v = p.lnx_b[hj]; break; }
        *(f32_a*)(lds + LD_PT + i * 4) = v; }
}
DI f32x4 ptab(const unsigned char* lds, int row, int lane, int n) { return *(const f32x4_a*)(lds + LD_PT + row * 256 + (16 * n + 4 * (lane >> 4)) * 4); }
struct RawQ { u32x2 c[4], pl[4]; };
DI void load_raw(const bf16_t* P, const SubIn& si, int colbase, int lane, RawQ& r) {
    const int t = lane & 15, q = lane >> 4;
    const bf16_t* pc = P + (size_t)(si.row0 + t) * NP + RC + colbase + 4 * q;
    const bf16_t* pp = P + (size_t)(si.prevrow >= 0 ? si.prevrow : MTOK + NDB) * NP + RC + colbase + 4 * q;
#pragma unroll
    for (int n = 0; n < 4; ++n) { r.c[n] = *(const u32x2*)(pc + 16 * n); r.pl[n] = *(const u32x2*)(pp + 16 * n); }
}
DI f32x4 mix_raw(const unsigned char* lds, const RawQ& r, const SubIn& si, int ptrow, int lane, int n) {
    const bool first = (lane & 15) == 0;
    const u32x2 c = r.c[n]; u32x2 pv; pv.x = dppu<0x111>(c.x); pv.y = dppu<0x111>(c.y);
    pv.x = first ? r.pl[n].x : pv.x; pv.y = first ? r.pl[n].y : pv.y;
    const f32x4 mu = ptab(lds, ptrow, lane, n);
    const f32x4 cv = {bflo(c.x), bfhi(c.x), bflo(c.y), bfhi(c.y)}, pvv = {bflo(pv.x), bfhi(pv.x), bflo(pv.y), bfhi(pv.y)};
    return cv + mu * (pvv - cv);
}

DI void load_lead(const Params& p, const SubIn& si, int lane, RawQ& qwl, RawQ& qal) {
    const bf16_t* P = (const bf16_t*)(p.ws + WS_P);
    load_raw(P, si, 1536, lane, qwl); load_raw(P, si, 1600, lane, qal);
}
template <bool ALLV> DI void precompute(const Params& p, unsigned char* lds, unsigned char* rb, const SubIn& si, int lane, float& bonus, const RawQ& qwl, const RawQ& qal) {
    asm volatile("" : "+v"(lane));
    const bf16_t* P = (const bf16_t*)(p.ws + WS_P);
    const int t = lane & 15, q = lane >> 4;
    const float validf = ALLV ? 1.0f : (t < si.nvalid ? 1.0f : 0.0f);
    const f32x4 z4 = {0.f, 0.f, 0.f, 0.f};
    RawQ qk, qr, qv;
    load_raw(P, si, 512 + si.h * 64, lane, qk);
    f32x4 lw[4], av[4];
    { f32x4 wl[4];
#pragma unroll
      for (int n = 0; n < 4; ++n) { wl[n] = mix_raw(lds, qwl, si, 4, lane, n);
#pragma unroll
          for (int e = 0; e < 4; ++e) wl[n][e] = 1.0f - 2.0f * __builtin_amdgcn_rcpf(1.0f + __expf(2.0f * wl[n][e])); }
      const s16x8 tw0 = mk8(pk4(wl[0]), pk4(wl[1])), tw1 = mk8(pk4(wl[2]), pk4(wl[3]));
#pragma unroll
      for (int mt = 0; mt < 4; ++mt) { const s16x8 a0_ = *(const s16x8_a*)(lds + LD_WD + ((mt * 2 + 0) * 64 + lane) * 16), a1_ = *(const s16x8_a*)(lds + LD_WD + ((mt * 2 + 1) * 64 + lane) * 16);
          const f32x4 d = MFMA32(a1_, tw1, MFMA32(a0_, tw0, z4)); const f32x4 w0 = ptab(lds, 6, lane, mt);
#pragma unroll
          for (int e = 0; e < 4; ++e) lw[mt][e] = -0.6065306597126334f * sigmoidf_(d[e] + w0[e]) * validf; } }
    load_raw(P, si, si.h * 64, lane, qr); load_raw(P, si, 1024 + si.h * 64, lane, qv);
    { f32x4 al[4];
#pragma unroll
      for (int n = 0; n < 4; ++n) al[n] = mix_raw(lds, qal, si, 5, lane, n);
      const s16x8 ta0 = mk8(pk4(al[0]), pk4(al[1])), ta1 = mk8(pk4(al[2]), pk4(al[3]));
#pragma unroll
      for (int mt = 0; mt < 4; ++mt) { const s16x8 a0_ = *(const s16x8_a*)(lds + LD_WA + ((mt * 2 + 0) * 64 + lane) * 16), a1_ = *(const s16x8_a*)(lds + LD_WA + ((mt * 2 + 1) * 64 + lane) * 16);
          const f32x4 d = MFMA32(a1_, ta1, MFMA32(a0_, ta0, z4)); const f32x4 a0 = ptab(lds, 7, lane, mt);
#pragma unroll
          for (int e = 0; e < 4; ++e) av[mt][e] = sigmoidf_(d[e] + a0[e]); } }
    f32x4 kr[4];
    float ss = 0.f, bon = 0.f;
#pragma unroll
    for (int n = 0; n < 4; ++n) {
        kr[n] = mix_raw(lds, qk, si, 1, lane, n) * validf; const f32x4 kkw = ptab(lds, 8, lane, n);
#pragma unroll
        for (int e = 0; e < 4; ++e) { const float kk = kr[n][e] * kkw[e]; ss += kk * kk; }
    }
    ss += __shfl_xor(ss, 16); ss += __shfl_xor(ss, 32);
    const float inv = 1.0f / fmaxf(sqrtf(ss), 1e-12f);
    u32x2 pa[4], pr_[4], pb[4], pk[4];
#pragma unroll
    for (int n = 0; n < 4; ++n) {
        asm volatile("" ::: "memory");
        const f32x4 kkw = ptab(lds, 8, lane, n), kaw = ptab(lds, 9, lane, n), rkw = ptab(lds, 10, lane, n);
        const f32x4 rrn = mix_raw(lds, qr, si, 0, lane, n) * validf, vrn = mix_raw(lds, qv, si, 2, lane, n) * validf;
        f32x4 cum = lw[n];
#pragma unroll
        for (int e = 0; e < 4; ++e) { cum[e] += dppf<0x111>(cum[e]); cum[e] += dppf<0x112>(cum[e]); cum[e] += dppf<0x114>(cum[e]); cum[e] += dppf<0x118>(cum[e]); }
        f32x4 at, rt, bt, kt, bh, kh, gam;
#pragma unroll
        for (int e = 0; e < 4; ++e) {
            const float er = __expf(cum[e]);
            const float ea = __int_as_float(__builtin_amdgcn_update_dpp(0x3f800000, __float_as_int(er), 0x111, 0xf, 0xf, false));
            const float ei = __builtin_amdgcn_rcpf(er), g15 = __shfl(er, (lane & 48) | 15), eh = g15 * ei;
            const float kkn = kr[n][e] * kkw[e] * inv, be = kkn * av[n][e], km = kr[n][e] * (1.0f + (av[n][e] - 1.0f) * kaw[e]);
            bon += rrn[e] * km * rkw[e];
            at[e] = -kkn * ea; rt[e] = rrn[e] * er; bt[e] = be * ei; kt[e] = km * ei; bh[e] = be * eh; kh[e] = km * eh; gam[e] = g15;
        }
        pa[n] = pk4(at); pr_[n] = pk4(rt); pb[n] = pk4(bt); pk[n] = pk4(kt);
        const u32x2 pbh = pk4(bh), pkh = pk4(kh), pv = pk4(vrn);
        *(u32x2_a*)(rb + SB_RT + t * WROW + (16 * n + 4 * q) * 2) = pr_[n];
        if (t == 15) *(f32x4_a*)(rb + SB_GAM + (16 * n + 4 * q) * 4) = gam;
        const int key0 = 16 * n + 4 * q;
        *(us_a*)(rb + SB_X0 + (key0 + 0) * 32 + t * 2) = (unsigned short)(pa[n].x & 0xffffu); *(us_a*)(rb + SB_X0 + (key0 + 1) * 32 + t * 2) = (unsigned short)(pa[n].x >> 16);
        *(us_a*)(rb + SB_X0 + (key0 + 2) * 32 + t * 2) = (unsigned short)(pa[n].y & 0xffffu); *(us_a*)(rb + SB_X0 + (key0 + 3) * 32 + t * 2) = (unsigned short)(pa[n].y >> 16);
        *(us_a*)(rb + SB_VT + (key0 + 0) * 32 + t * 2) = (unsigned short)(pv.x & 0xffffu); *(us_a*)(rb + SB_VT + (key0 + 1) * 32 + t * 2) = (unsigned short)(pv.x >> 16);
        *(us_a*)(rb + SB_VT + (key0 + 2) * 32 + t * 2) = (unsigned short)(pv.y & 0xffffu); *(us_a*)(rb + SB_VT + (key0 + 3) * 32 + t * 2) = (unsigned short)(pv.y >> 16);
        *(us_a*)(rb + SB_BK + (key0 + 0) * BKROW + t * 2) = (unsigned short)(pbh.x & 0xffffu); *(us_a*)(rb + SB_BK + (key0 + 1) * BKROW + t * 2) = (unsigned short)(pbh.x >> 16);
        *(us_a*)(rb + SB_BK + (key0 + 2) * BKROW + t * 2) = (unsigned short)(pbh.y & 0xffffu); *(us_a*)(rb + SB_BK + (key0 + 3) * BKROW + t * 2) = (unsigned short)(pbh.y >> 16);
        *(us_a*)(rb + SB_BK + (key0 + 0) * BKROW + 32 + t * 2) = (unsigned short)(pkh.x & 0xffffu); *(us_a*)(rb + SB_BK + (key0 + 1) * BKROW + 32 + t * 2) = (unsigned short)(pkh.x >> 16);
        *(us_a*)(rb + SB_BK + (key0 + 2) * BKROW + 32 + t * 2) = (unsigned short)(pkh.y & 0xffffu); *(us_a*)(rb + SB_BK + (key0 + 3) * BKROW + 32 + t * 2) = (unsigned short)(pkh.y >> 16);
    }
    bon += __shfl_xor(bon, 16); bon += __shfl_xor(bon, 32); bonus = bon;
    f32x4 Aab, Aak, Arb, Ark;
    { const s16x8 At0 = mk8(pa[0], pa[1]), At1 = mk8(pa[2], pa[3]), Rt0 = mk8(pr_[0], pr_[1]), Rt1 = mk8(pr_[2], pr_[3]);
      const s16x8 Bt0 = mk8(pb[0], pb[1]), Bt1 = mk8(pb[2], pb[3]), Kt0 = mk8(pk[0], pk[1]), Kt1 = mk8(pk[2], pk[3]);
      Aab = MFMA32(At1, Bt1, MFMA32(At0, Bt0, z4)); Aak = MFMA32(At1, Kt1, MFMA32(At0, Kt0, z4));
      Arb = MFMA32(Rt1, Bt1, MFMA32(Rt0, Bt0, z4)); Ark = MFMA32(Rt1, Kt1, MFMA32(Rt0, Kt0, z4)); }
#pragma unroll
    for (int e = 0; e < 4; ++e) { const int trow = 4 * q + e; if (!(t < trow)) { Aab[e] = 0.f; Aak[e] = 0.f; } if (!(t <= trow)) { Arb[e] = 0.f; Ark[e] = 0.f; }
        *(us_a*)(rb + SB_ARK + trow * ARKROW + t * 2) = bf1(Arb[e]); *(us_a*)(rb + SB_ARK + trow * ARKROW + 32 + t * 2) = bf1(Ark[e]); }
    *(f32x4_a*)(rb + SB_AT + t * 64 + 16 * q) = Aab;
    float x[16];
#pragma unroll
    for (int s = 0; s < 16; ++s) x[s] = (s == t) ? 1.0f : 0.0f;
#pragma unroll
    for (int c = 14; c >= 0; --c) {
        if ((c & 1) == 0) asm volatile("" ::: "memory");
        float acc = 0.f;
#pragma unroll
        for (int s4 = (c + 1) / 4; s4 < 4; ++s4) { const f32x4 a = *(const f32x4_a*)(rb + SB_AT + c * 64 + s4 * 16);
#pragma unroll
            for (int e = 0; e < 4; ++e) if (4 * s4 + e > c) acc += x[4 * s4 + e] * a[e]; }
        if (c < t) x[c] = acc;
    }
    f32x4 tq;
#pragma unroll
    for (int e = 0; e < 4; ++e) tq[e] = q == 0 ? x[e] : (q == 1 ? x[4 + e] : (q == 2 ? x[8 + e] : x[12 + e]));
    const s16x4 tB = mk4(pk4(tq));
    f32x4 Wd[4];
#pragma unroll
    for (int m = 0; m < 4; ++m) { const s16x4 aop = mk4(*(const u32x2_a*)(rb + SB_X0 + (16 * m + t) * 32 + 8 * q)); Wd[m] = MFMA16(aop, tB, z4); }
    const f32x4 Qt = MFMA16(mk4(pk4(Aak)), tB, z4);
    const s16x4 qB = mk4(pk4(Qt));
    f32x4 X0d[4];
#pragma unroll
    for (int m = 0; m < 4; ++m) { const s16x4 aop = mk4(*(const u32x2_a*)(rb + SB_VT + (16 * m + t) * 32 + 8 * q)); X0d[m] = MFMA16(aop, qB, z4); }
#pragma unroll
    for (int m = 0; m < 4; ++m) { *(u32x2_a*)(rb + SB_W + t * WROW + (16 * m + 4 * q) * 2) = pk4(Wd[m]);
#pragma unroll
        for (int e = 0; e < 4; ++e) *(f32_a*)(rb + SB_X0 + (16 * m + 4 * q + e) * 64 + t * 4) = X0d[m][e]; }
}

DI void epilogue_core(const Params& p, unsigned char* lds, const SubIn& si, int lane, f32x4 (&o)[4], float bonus, const RawQ& qg, const RawQ& qv) {
    const int t = lane & 15, q = lane >> 4, hb = si.h * 64 + 4 * q;
    float sm = 0.f;
#pragma unroll
    for (int n = 0; n < 4; ++n) sm += (o[n][0] + o[n][1]) + (o[n][2] + o[n][3]);
    sm += __shfl_xor(sm, 16); sm += __shfl_xor(sm, 32);
    const float mean = sm * (1.0f / 64.0f); float vs = 0.f;
#pragma unroll
    for (int n = 0; n < 4; ++n)
#pragma unroll
        for (int e = 0; e < 4; ++e) { o[n][e] -= mean; vs += o[n][e] * o[n][e]; }
    vs += __shfl_xor(vs, 16); vs += __shfl_xor(vs, 32);
    const float rstd = rsqrtf(vs * (1.0f / 64.0f) + 64e-5f);
    bf16_t* yc = (bf16_t*)(p.ws + WS_YC) + (size_t)(si.row0 + t) * D + 512 + hb;
#pragma unroll
    for (int n = 0; n < 4; ++n) { const f32x4 lg = ptab(lds, 11, lane, n), lb = ptab(lds, 12, lane, n), gv = mix_raw(lds, qg, si, 3, lane, n), vv = mix_raw(lds, qv, si, 2, lane, n); f32x4 y;
#pragma unroll
        for (int e = 0; e < 4; ++e) y[e] = (o[n][e] * rstd * lg[e] + lb[e] + bonus * vv[e]) * siluf_(gv[e]);
        if (t < si.nvalid) *(u32x2*)(yc + 16 * n) = pk4(y); }
}
DI void scan_epilogue(const Params& p, unsigned char* lds, unsigned char* rb, const SubIn& si, int lane, float bonus, const RawQ& qg, const RawQ& qv) {
    asm volatile("" : "+v"(lane));
    const int t = lane & 15, q = lane >> 4;
    f32x4 o[4];
#pragma unroll
    for (int n = 0; n < 4; ++n)
#pragma unroll
        for (int e = 0; e < 4; ++e) o[n][e] = *(const f32_a*)(rb + SB_X0 + (16 * n + 4 * q + e) * 64 + t * 4);
    epilogue_core(p, lds, si, lane, o, bonus, qg, qv);
}

template <int IDENT> DI void chain_step_seg2(const unsigned char* rb, int v0, int c, int q, f32x4 (&st)[2][4], float* oz, bf16_t* rho) {
    const unsigned char* wr_ = rb + SB_W + c * WROW + 8 * q; const unsigned char* rr_ = rb + SB_RT + c * WROW + 8 * q; const unsigned char* ar = rb + SB_ARK + c * ARKROW + 8 * q;
    const s16x8 wa1 = mk8(*(const u32x2_a*)(wr_), *(const u32x2_a*)(wr_ + 32)), wa2 = mk8(*(const u32x2_a*)(wr_ + 64), *(const u32x2_a*)(wr_ + 96));
    const s16x8 ra1 = mk8(*(const u32x2_a*)(rr_), *(const u32x2_a*)(rr_ + 32)), ra2 = mk8(*(const u32x2_a*)(rr_ + 64), *(const u32x2_a*)(rr_ + 96));
    const s16x8 ark = mk8(*(const u32x2_a*)(ar), *(const u32x2_a*)(ar + 32));
    s16x8 bk[4]; f32x4 g[4];
#pragma unroll
    for (int m = 0; m < 4; ++m) { const unsigned char* bp = rb + SB_BK + (16 * m + c) * BKROW + 8 * q; bk[m] = mk8(*(const u32x2_a*)(bp), *(const u32x2_a*)(bp + 32)); g[m] = *(const f32x4_a*)(rb + SB_GAM + (16 * m + 4 * q) * 4); }
    const int i0 = 16 * v0 + c, i1 = i0 + 16;
    const s16x8 b1a = mk8(pk4(st[0][0]), pk4(st[0][1])), b2a = mk8(pk4(st[0][2]), pk4(st[0][3]));
    const s16x8 b1b = mk8(pk4(st[1][0]), pk4(st[1][1])), b2b = mk8(pk4(st[1][2]), pk4(st[1][3]));
    f32x4 Ua = {0.f, 0.f, 0.f, 0.f}, Ub = Ua, Oa = Ua, Ob = Ua;
    if (!IDENT) { Ua = *(const f32x4_a*)(rb + SB_X0 + i0 * 64 + 16 * q); Ub = *(const f32x4_a*)(rb + SB_X0 + i1 * 64 + 16 * q); }
    u32x2 vta, vtb; vta.x = 0u; vta.y = 0u; vtb = vta;
    if (!IDENT) { vta = *(const u32x2_a*)(rb + SB_VT + i0 * 32 + 8 * q); vtb = *(const u32x2_a*)(rb + SB_VT + i1 * 32 + 8 * q); }
    Ua = MFMA32(wa1, b1a, Ua); Ub = MFMA32(wa1, b1b, Ub);
    Oa = MFMA32(ra1, b1a, Oa); Ob = MFMA32(ra1, b1b, Ob);
    Ua = MFMA32(wa2, b2a, Ua); Ub = MFMA32(wa2, b2b, Ub);
    Oa = MFMA32(ra2, b2a, Oa); Ob = MFMA32(ra2, b2b, Ob);
    const s16x8 uva = mk8(pk4(Ua), vta), uvb = mk8(pk4(Ub), vtb);
#pragma unroll
    for (int m = 0; m < 4; ++m) { st[0][m] = MFMA32(bk[m], uva, st[0][m] * g[m]); st[1][m] = MFMA32(bk[m], uvb, st[1][m] * g[m]); }
    Oa = MFMA32(ark, uva, Oa); Ob = MFMA32(ark, uvb, Ob);
    if (!IDENT) {
#pragma unroll
        for (int e = 0; e < 4; ++e) { oz[(size_t)(4 * q + e) * 512 + i0] = Oa[e]; oz[(size_t)(4 * q + e) * 512 + i1] = Ob[e]; } }
    else {
#pragma unroll
        for (int e = 0; e < 4; ++e) { rho[(size_t)(4 * q + e) * 512 + i0] = bf1(Oa[e]); rho[(size_t)(4 * q + e) * 512 + i1] = bf1(Ob[e]); } }
}

__device__ void scan_segments(const Params& p, unsigned char* lds, int item) {
    int tid_ = threadIdx.x; asm volatile("" : "+v"(tid_)); const int tid = tid_, w = tid >> 6, lane = tid & 63, q = lane >> 4, c = lane & 15;
    const int it = item >> 2, j = item & 3, b = it >> 3, h = it & 7, v = w & 3;
    float* OZ = (float*)(p.ws + WS_OZ); bf16_t* RHO = (bf16_t*)(p.ws + WS_RHO); float* BON = (float*)(p.ws + WS_BON); float* MN = (float*)(p.ws + WS_MN);
    unsigned char* rb = lds + w * SUBSZ;
    __syncthreads();
    fill_lora(p.w_dec2, h, w, lane, lds + LD_WD); fill_lora(p.w_a2, h, w, lane, lds + LD_WA); fill_params(p, h, lds);
    __syncthreads();
    const int v0 = (w & 1) * 2; const bool ident = (w & 2) != 0;
    f32x4 st[2][4];
#pragma unroll
    for (int nt = 0; nt < 2; ++nt)
#pragma unroll
        for (int m = 0; m < 4; ++m)
#pragma unroll
            for (int e = 0; e < 4; ++e) st[nt][m][e] = (ident && (16 * m + 4 * q + e) == (16 * (v0 + nt) + c)) ? 1.0f : 0.0f;
    const int seg0 = b * SEQ + j * 512;
#pragma unroll 1
    for (int mc = 0; mc < 4; ++mc) {
        SubIn si; si.h = h; si.row0 = seg0 + mc * 128 + w * 16; si.prevrow = (j == 0 && mc == 0 && w == 0) ? -1 : si.row0 - 1; si.nvalid = 16;
        float bonus;
#ifndef REPPRE
#define REPPRE 1
#endif
#ifndef REPCH
#define REPCH 1
#endif
#pragma unroll 1
        for (int rp = 0; rp < REPPRE; ++rp) { RawQ qwl, qal; load_lead(p, si, lane, qwl, qal); precompute<true>(p, lds, rb, si, lane, bonus, qwl, qal); }
        if (lane < 16) BON[(size_t)(si.row0 + lane) * 8 + h] = bonus;
        unsigned d0 = 0u, d1 = 0u;
        if (mc < 3) {
            const bf16_t* nx = (const bf16_t*)(p.ws + WS_P) + (size_t)(si.row0 + 128 + c) * NP + RC; const int sg = q == 0 ? h * 64 : (q == 1 ? 512 + h * 64 : (q == 2 ? 1024 + h * 64 : 1664 + h * 64));
            d0 = *(const unsigned*)(nx + sg); d1 = *(const unsigned*)(nx + 1536 + (q & 1) * 64); }
        __syncthreads();
        if (w < 4) { int ln = lane; asm volatile("" : "+v"(ln)); const int cc = ln & 15, qq = ln >> 4;
            __builtin_amdgcn_s_setprio(3);
#if REPCH > 1
            f32x4 sv[2][4];
            for (int a_ = 0; a_ < 2; ++a_) for (int b_ = 0; b_ < 4; ++b_) sv[a_][b_] = st[a_][b_];
#pragma unroll 1
            for (int rc = 0; rc < REPCH; ++rc) {
            for (int a_ = 0; a_ < 2; ++a_) for (int b_ = 0; b_ < 4; ++b_) st[a_][b_] = sv[a_][b_];
#endif
#pragma unroll 1
            for (int d = 0; d < 8; ++d) { const size_t ro = (size_t)(seg0 + mc * 128 + d * 16) * 512 + h * 64;
                if (!ident) chain_step_seg2<0>(lds + d * SUBSZ, v0, cc, qq, st, OZ + ro, nullptr); else chain_step_seg2<1>(lds + d * SUBSZ, v0, cc, qq, st, nullptr, RHO + ro); }
#if REPCH > 1
            }
#endif
            __builtin_amdgcn_s_setprio(0);
        } else if (gridDim.x == 256) {
            conv_items(p, (int)blockIdx.x + 256 * mc, 1024, mc == 0 ? MTOK / 16 : 0x7fffffff & ((int)blockIdx.x + 256 * mc + 1), tid - 256, 4);
        }
        asm volatile("" :: "v"(d0), "v"(d1));
        __syncthreads();
    }
    if (w < 4) {
#pragma unroll
        for (int nt = 0; nt < 2; ++nt) { float* so = MN + ((size_t)item * 2 + (ident ? 1 : 0)) * 4096 + (16 * (v0 + nt) + c) * 64 + 4 * q;
#pragma unroll
            for (int m = 0; m < 4; ++m) { const f32x4 sv = st[nt][m];
                __hip_atomic_store((unsigned long long*)(so + 16 * m), (unsigned long long)__float_as_uint(sv[0]) | ((unsigned long long)__float_as_uint(sv[1]) << 32), __ATOMIC_RELAXED, __HIP_MEMORY_SCOPE_AGENT);
                __hip_atomic_store((unsigned long long*)(so + 16 * m + 2), (unsigned long long)__float_as_uint(sv[2]) | ((unsigned long long)__float_as_uint(sv[3]) << 32), __ATOMIC_RELAXED, __HIP_MEMORY_SCOPE_AGENT); } }
        asm volatile("s_waitcnt vmcnt(0)" ::: "memory");
        if (lane == 0) (void)__hip_atomic_fetch_add((unsigned*)(p.ws + WS_CHC) + 64 * it, 1u, __ATOMIC_RELAXED, __HIP_MEMORY_SCOPE_AGENT); }
}

struct FxIn { RawQ qg, qv; f32x4 o[4]; s16x8 r0, r1; float bonus; };
DI void fx_load(const Params& p, FxIn& in, int seg0, int mc, int j, int h, int w, int ln) {
    SubIn si; si.h = h; si.row0 = seg0 + mc * 128 + w * 16; si.prevrow = (j == 0 && mc == 0 && w == 0) ? -1 : si.row0 - 1; si.nvalid = 16;
    const bf16_t* P = (const bf16_t*)(p.ws + WS_P); const int t = ln & 15, qq = ln >> 4;
    load_raw(P, si, 1664 + h * 64, ln, in.qg); load_raw(P, si, 1024 + h * 64, ln, in.qv);
    const size_t ro = (size_t)(si.row0 + t) * 512 + h * 64;
    const float* OZ = (const float*)(p.ws + WS_OZ); const bf16_t* RHO = (const bf16_t*)(p.ws + WS_RHO);
#pragma unroll
    for (int m = 0; m < 4; ++m) in.o[m] = *(const f32x4*)(OZ + ro + 16 * m + 4 * qq);
    in.r0 = *(const s16x8*)(RHO + ro + 8 * qq); in.r1 = *(const s16x8*)(RHO + ro + 32 + 8 * qq);
    in.bonus = ((const float*)(p.ws + WS_BON))[(size_t)(si.row0 + t) * 8 + h];
}
constexpr int LD_SBF = 69632, LD_MT = 79872;
DI void sub_barrier4(unsigned char* lds, unsigned& gen) {
    asm volatile("s_waitcnt vmcnt(0) lgkmcnt(0)" ::: "memory");
    ++gen;
    if ((threadIdx.x & 63) == 0) (void)__hip_atomic_fetch_add((unsigned*)(lds + LD_XB + 8), 1u, __ATOMIC_RELAXED, __HIP_MEMORY_SCOPE_WORKGROUP);
    while (__hip_atomic_load((unsigned*)(lds + LD_XB + 8), __ATOMIC_RELAXED, __HIP_MEMORY_SCOPE_WORKGROUP) < 4u * gen) __builtin_amdgcn_s_sleep(1);
    asm volatile("" ::: "memory");
}
__device__ void fix_sstart4(const Params& p, unsigned char* lds, int item, int wq, int lane) {
    const int it = item >> 2, j = item & 3; if (j == 0) return;
    const int q = lane >> 4, c = lane & 15, t256 = wq * 64 + lane, ri = t256 >> 3, kg = (t256 & 7) * 8;
    const float* MN = (const float*)(p.ws + WS_MN) + (size_t)it * 4 * 2 * 4096;
    unsigned char* SBF = lds + LD_SBF; unsigned char* MT = lds + LD_MT;
    { const unsigned* chc = (const unsigned*)(p.ws + WS_CHC) + 64 * it; unsigned sp = 0u;
      while ((unsigned)__builtin_amdgcn_readfirstlane(__hip_atomic_load(chc, __ATOMIC_RELAXED, __HIP_MEMORY_SCOPE_AGENT)) < 16u) { __builtin_amdgcn_s_sleep(2); if (++sp > (1u << 22)) break; }
      asm volatile("s_waitcnt vmcnt(0)" ::: "memory"); }
    const int nst = j == 3 ? 3 : j - 1;
    unsigned gen = 0u;
#pragma unroll
    for (int rr = 0; rr < 64; rr += 32) { const f32x4 a0 = *(const f32x4*)(MN + (ri + rr) * 64 + kg), a1 = *(const f32x4*)(MN + (ri + rr) * 64 + kg + 4);
        u32x4v o; o.x = cvt_pk_bf16(a0[0], a0[1]); o.y = cvt_pk_bf16(a0[2], a0[3]); o.z = cvt_pk_bf16(a1[0], a1[1]); o.w = cvt_pk_bf16(a1[2], a1[3]);
        *(u32x4v_a*)(SBF + (ri + rr) * 144 + kg * 2) = o; }
#pragma unroll 1
    for (int jj = 1; jj <= nst; ++jj) {
        const float* Nj = MN + (size_t)jj * 2 * 4096; const float* Mj = Nj + 4096;
#pragma unroll
        for (int rr = 0; rr < 64; rr += 32) { const f32x4 m0 = *(const f32x4*)(Mj + (ri + rr) * 64 + kg), m1 = *(const f32x4*)(Mj + (ri + rr) * 64 + kg + 4);
#pragma unroll
            for (int e = 0; e < 4; ++e) { *(us_a*)(MT + (kg + e) * 144 + (ri + rr) * 2) = bf1(m0[e]); *(us_a*)(MT + (kg + 4 + e) * 144 + (ri + rr) * 2) = bf1(m1[e]); } }
        f32x4 ci[4];
#pragma unroll
        for (int ct = 0; ct < 4; ++ct)
#pragma unroll
            for (int e = 0; e < 4; ++e) ci[ct][e] = Nj[(16 * wq + 4 * q + e) * 64 + 16 * ct + c];
        sub_barrier4(lds, gen);
        const s16x8 sa0 = *(const s16x8_a*)(SBF + (16 * wq + c) * 144 + (8 * q) * 2), sa1 = *(const s16x8_a*)(SBF + (16 * wq + c) * 144 + (32 + 8 * q) * 2);
        f32x4 dn[4];
#pragma unroll
        for (int ct = 0; ct < 4; ++ct) { const s16x8 b0 = *(const s16x8_a*)(MT + (16 * ct + c) * 144 + (8 * q) * 2), b1 = *(const s16x8_a*)(MT + (16 * ct + c) * 144 + (32 + 8 * q) * 2);
            dn[ct] = MFMA32(sa1, b1, MFMA32(sa0, b0, ci[ct])); }
        sub_barrier4(lds, gen);
#pragma unroll
        for (int ct = 0; ct < 4; ++ct)
#pragma unroll
            for (int e = 0; e < 4; ++e) { const int i = 16 * wq + 4 * q + e, key = 16 * ct + c;
                if (jj == 3) p.out[OFF_WKVP + (size_t)it * 4096 + i * 64 + key] = dn[ct][e];
                else *(us_a*)(SBF + i * 144 + key * 2) = bf1(dn[ct][e]); }
    }
}
__device__ void scan_fixup(const Params& p, unsigned char* lds, int item, const int skip_tiles, const bool sdone) {
    int tid_ = threadIdx.x; asm volatile("" : "+v"(tid_)); const int tid = tid_, w = tid >> 6, lane = tid & 63, q = lane >> 4, c = lane & 15;
    const int it = item >> 2, j = item & 3, b = it >> 3, h = it & 7;
    const float* OZ = (const float*)(p.ws + WS_OZ); const bf16_t* RHO = (const bf16_t*)(p.ws + WS_RHO); const float* BON = (const float*)(p.ws + WS_BON);
    const float* MN = (const float*)(p.ws + WS_MN) + (size_t)it * 4 * 2 * 4096; const bf16_t* P = (const bf16_t*)(p.ws + WS_P);
    float* SA = (float*)lds; float* SBb = SA + 4096; unsigned char* SBF = lds + LD_SBF;
    __syncthreads();
    fill_params(p, h, lds);
    const int seg0 = b * SEQ + j * 512;
    int ln = lane; asm volatile("" : "+v"(ln));
    FxIn fin[2]; fx_load(p, fin[0], seg0, 0, j, h, w, ln);
    if (!sdone) {
    if (tid < 64) { const unsigned* chc = (const unsigned*)(p.ws + WS_CHC) + 64 * it; unsigned sp = 0u;
        while ((unsigned)__builtin_amdgcn_readfirstlane(__hip_atomic_load(chc, __ATOMIC_RELAXED, __HIP_MEMORY_SCOPE_AGENT)) < 16u) { __builtin_amdgcn_s_sleep(2); if (++sp > (1u << 22)) break; }
        asm volatile("s_waitcnt vmcnt(0)" ::: "memory"); }
    __syncthreads();
    const int ri = tid >> 3, kg = (tid & 7) * 8;
    const int nst = j == 0 ? 0 : (j == 3 ? 3 : j - 1);
    unsigned char* MT = lds + LD_MT;
    const int rt = w >> 1, ct0 = 2 * (w & 1);
    f32x4 mA[4], mB[4]; float nd[4][2][4];
#pragma unroll
    for (int jj = 1; jj < 4; ++jj) { mA[jj] = mB[jj] = (f32x4){0.f, 0.f, 0.f, 0.f};
#pragma unroll
        for (int tt = 0; tt < 2; ++tt)
#pragma unroll
            for (int e = 0; e < 4; ++e) nd[jj][tt][e] = 0.f;
        if (jj <= nst) { const float* Nj = MN + (size_t)jj * 2 * 4096; mA[jj] = *(const f32x4*)(Nj + 4096 + ri * 64 + kg); mB[jj] = *(const f32x4*)(Nj + 4096 + ri * 64 + kg + 4);
#pragma unroll
            for (int tt = 0; tt < 2; ++tt)
#pragma unroll
                for (int e = 0; e < 4; ++e) nd[jj][tt][e] = Nj[(16 * rt + 4 * q + e) * 64 + 16 * (ct0 + tt) + c]; } }
    { f32x4 a0 = {0.f, 0.f, 0.f, 0.f}, a1 = a0; if (j > 0) { a0 = *(const f32x4*)(MN + ri * 64 + kg); a1 = *(const f32x4*)(MN + ri * 64 + kg + 4); }
      u32x4v o; o.x = cvt_pk_bf16(a0[0], a0[1]); o.y = cvt_pk_bf16(a0[2], a0[3]); o.z = cvt_pk_bf16(a1[0], a1[1]); o.w = cvt_pk_bf16(a1[2], a1[3]);
      *(u32x4v_a*)(SBF + ri * 144 + kg * 2) = o; }
#pragma unroll
    for (int jj = 1; jj <= 3; ++jj) if (jj <= nst) {
#pragma unroll
        for (int e = 0; e < 4; ++e) { *(us_a*)(MT + (kg + e) * 144 + ri * 2) = bf1(mA[jj][e]); *(us_a*)(MT + (kg + 4 + e) * 144 + ri * 2) = bf1(mB[jj][e]); }
        __syncthreads();
        const s16x8 sa0 = *(const s16x8_a*)(SBF + (16 * rt + c) * 144 + (8 * q) * 2), sa1 = *(const s16x8_a*)(SBF + (16 * rt + c) * 144 + (32 + 8 * q) * 2);
        f32x4 dn[2];
#pragma unroll
        for (int tt = 0; tt < 2; ++tt) { const s16x8 b0 = *(const s16x8_a*)(MT + (16 * (ct0 + tt) + c) * 144 + (8 * q) * 2), b1 = *(const s16x8_a*)(MT + (16 * (ct0 + tt) + c) * 144 + (32 + 8 * q) * 2);
            const f32x4 ci = {nd[jj][tt][0], nd[jj][tt][1], nd[jj][tt][2], nd[jj][tt][3]}; dn[tt] = MFMA32(sa1, b1, MFMA32(sa0, b0, ci)); }
        __syncthreads();
#pragma unroll
        for (int tt = 0; tt < 2; ++tt)
#pragma unroll
            for (int e = 0; e < 4; ++e) { const int i = 16 * rt + 4 * q + e, key = 16 * (ct0 + tt) + c;
                if (jj == 3) p.out[OFF_WKVP + (size_t)it * 4096 + i * 64 + key] = dn[tt][e];
                else *(us_a*)(SBF + i * 144 + key * 2) = bf1(dn[tt][e]); }
    }
    }
    __syncthreads();
    if (!skip_tiles)
#pragma unroll
    for (int mc = 0; mc < 4; ++mc) {
        if (mc < 3) fx_load(p, fin[(mc + 1) & 1], seg0, mc + 1, j, h, w, ln);
        FxIn& in = fin[mc & 1];
        SubIn si; si.h = h; si.row0 = seg0 + mc * 128 + w * 16; si.prevrow = (j == 0 && mc == 0 && w == 0) ? -1 : si.row0 - 1; si.nvalid = 16;
        const int t = ln & 15, qq = ln >> 4;
        if (j > 0) {
#pragma unroll
            for (int m = 0; m < 4; ++m) { const s16x8 a0_ = *(const s16x8_a*)(SBF + (16 * m + t) * 144 + (8 * qq) * 2), a1_ = *(const s16x8_a*)(SBF + (16 * m + t) * 144 + (32 + 8 * qq) * 2);
                in.o[m] = MFMA32(a1_, in.r1, MFMA32(a0_, in.r0, in.o[m])); } }
        epilogue_core(p, lds, si, ln, in.o, in.bonus, in.qg, in.qv);
    }
    __syncthreads();
}

DI void sample_chain(unsigned char* rb, int lane, const float* s_in, float* s_out) {
    asm volatile("" : "+v"(lane));
    const int c = lane & 15, q = lane >> 4;
    f32x4 st[4][4];
#pragma unroll
    for (int v = 0; v < 4; ++v)
#pragma unroll
        for (int m = 0; m < 4; ++m) st[v][m] = *(const f32x4*)(s_in + (16 * v + c) * 64 + 16 * m + 4 * q);
    const unsigned char* wr_ = rb + SB_W + c * WROW + 8 * q; const unsigned char* rr_ = rb + SB_RT + c * WROW + 8 * q; const unsigned char* ar = rb + SB_ARK + c * ARKROW + 8 * q;
    const s16x8 wa1 = mk8(*(const u32x2_a*)(wr_), *(const u32x2_a*)(wr_ + 32)), wa2 = mk8(*(const u32x2_a*)(wr_ + 64), *(const u32x2_a*)(wr_ + 96));
    const s16x8 ra1 = mk8(*(const u32x2_a*)(rr_), *(const u32x2_a*)(rr_ + 32)), ra2 = mk8(*(const u32x2_a*)(rr_ + 64), *(const u32x2_a*)(rr_ + 96));
    const s16x8 ark = mk8(*(const u32x2_a*)(ar), *(const u32x2_a*)(ar + 32));
    s16x8 bk[4]; f32x4 g[4];
#pragma unroll
    for (int m = 0; m < 4; ++m) { const unsigned char* bp = rb + SB_BK + (16 * m + c) * BKROW + 8 * q; bk[m] = mk8(*(const u32x2_a*)(bp), *(const u32x2_a*)(bp + 32)); g[m] = *(const f32x4_a*)(rb + SB_GAM + (16 * m + 4 * q) * 4); }
#pragma unroll
    for (int v = 0; v < 4; ++v) {
        const int i = 16 * v + c;
        const s16x8 b1 = mk8(pk4(st[v][0]), pk4(st[v][1])), b2 = mk8(pk4(st[v][2]), pk4(st[v][3]));
        f32x4 U = *(const f32x4_a*)(rb + SB_X0 + i * 64 + 16 * q);
        U = MFMA32(wa2, b2, MFMA32(wa1, b1, U));
        f32x4 O = {0.f, 0.f, 0.f, 0.f};
        O = MFMA32(ra2, b2, MFMA32(ra1, b1, O));
        const s16x8 uv = mk8(pk4(U), *(const u32x2_a*)(rb + SB_VT + i * 32 + 8 * q));
        O = MFMA32(ark, uv, O);
#pragma unroll
        for (int m = 0; m < 4; ++m) { const f32x4 sn = MFMA32(bk[m], uv, st[v][m] * g[m]); *(f32x4*)(s_out + (16 * v + c) * 64 + 16 * m + 4 * q) = sn; }
        *(f32x4_a*)(rb + SB_X0 + i * 64 + 16 * q) = O;
    }
}
__device__ void scan_tail(const Params& p, unsigned char* lds) {
    int tid_ = threadIdx.x; asm volatile("" : "+v"(tid_)); const int tid = tid_, w = tid >> 6, lane = tid & 63;
    const int nb = gridDim.x, bid = blockIdx.x; const bool conc = nb == 256;
    unsigned char* rb = lds + w * SUBSZ;
#pragma unroll 1
    for (int ms = conc ? 0 : bid; ms < (conc ? 1 : NDB); ms += (conc ? 1 : nb)) {
        int h, b;
        if (conc) { const int it = bid >> 2, k = (it >> 3) * 4 + (bid & 3); h = it & 7; b = (k >> 1) * 8 + (k & 1) * 4 + w; }
        else { h = ms & 7; b = (ms >> 3) * 8 + w; __syncthreads();
               fill_lora(p.w_dec2, h, w, lane, lds + LD_WD); fill_lora(p.w_a2, h, w, lane, lds + LD_WA); fill_params(p, h, lds); __syncthreads(); }
        if (w < (conc ? 4 : 8)) {
            SubIn si; si.h = h; si.row0 = MPR + b * DSEQ; si.prevrow = MTOK + b; si.nvalid = DSEQ;
            float bonus;
            const size_t so = (size_t)(b * 8 + h) * 4096;
            const float th0 = p.state_wkv[so + lane * 32], th1 = p.state_wkv[so + 2048 + lane * 32];
            { RawQ qwl, qal; load_lead(p, si, lane, qwl, qal); precompute<false>(p, lds, rb, si, lane, bonus, qwl, qal); }
            asm volatile("" :: "v"(th0), "v"(th1));
            sample_chain(rb, lane, p.state_wkv + so, p.out + OFF_WKVS + so);
            { RawQ qg, qv2; load_raw((const bf16_t*)(p.ws + WS_P), si, 1664 + si.h * 64, lane, qg); load_raw((const bf16_t*)(p.ws + WS_P), si, 1024 + si.h * 64, lane, qv2);
              scan_epilogue(p, lds, rb, si, lane, bonus, qg, qv2); }
        }
    }
    if (!conc) __syncthreads();
    if (!conc) conv_items(p, bid, nb, MTOK / 32, tid, 8);
    else if (w >= 4) fix_sstart4(p, lds, bid, w - 4, lane);
}
__device__ void phase2(const Params& p, unsigned char* lds) {
    const int nb = gridDim.x, bid = blockIdx.x;
#pragma unroll 1
    for (int item = bid; item < 256; item += nb) scan_segments(p, lds, item);
    scan_tail(p, lds);
}
__device__ void phase2b(const Params& p, unsigned char* lds, const int skip_tiles) {
    const int nb = gridDim.x, bid = blockIdx.x;
#pragma unroll 1
    for (int item = bid; item < 256; item += nb) scan_fixup(p, lds, item, skip_tiles, nb == 256);
}

struct EpiResid {
    static constexpr bool PERM = false, AFTER_DRAIN = false;
    const float* xp; const float* xs; float* out; float* ss;
    __device__ __forceinline__ void operator()(const f32x4 (&acc)[2][2][4][2], const pg8::Unit& u, int wr, int wc, int fr, int fq) const {
        const int row0 = u.pm * 256 + wr * 64 + fr, col0 = u.pn * 256 + wc * 32 + 4 * fq;
#pragma unroll
        for (int ai = 0; ai < 2; ++ai)
#pragma unroll
            for (int m = 0; m < 4; ++m) {
                const int row = row0 + ai * 128 + m * 16;
                const float* xr = (row < MPR ? xp + (size_t)row * D : xs + (size_t)(row - MPR) * D) + col0; float* orow = out + (size_t)row * D + col0; float s = 0.f;
#pragma unroll
                for (int bj = 0; bj < 2; ++bj)
#pragma unroll
                    for (int n = 0; n < 2; ++n) { const f32x4 hv = *(const f32x4*)(xr + bj * 128 + n * 16) + acc[ai][bj][m][n]; *(f32x4*)(orow + bj * 128 + n * 16) = hv; s += hv[0] * hv[0] + hv[1] * hv[1] + hv[2] * hv[2] + hv[3] * hv[3]; }
                s += __shfl_xor(s, 16); s += __shfl_xor(s, 32);
                if (fq == 0) atomicAdd(ss + row, s);
            }
    }
};

__device__ __forceinline__ void group_barrier(unsigned* cnt, unsigned target) {
    asm volatile("s_waitcnt vmcnt(0)" ::: "memory");
    __syncthreads();
    if (threadIdx.x == 0) {
        __builtin_amdgcn_fence(__ATOMIC_RELEASE, "agent"); asm volatile("s_waitcnt vmcnt(0)" ::: "memory");
        (void)xb_add(cnt, 1u);
        unsigned sp = 0u; while (xb_ld(cnt) < target) { __builtin_amdgcn_s_sleep(1); if (++sp > (1u << 22)) break; }
        __builtin_amdgcn_fence(__ATOMIC_ACQUIRE, "agent"); asm volatile("s_waitcnt vmcnt(0)" ::: "memory");
    }
    __syncthreads();
}
__device__ void phase4(const Params& p, const int row_begin, const int row_end, const int first_wave, const int nw) {
    int tid_ = threadIdx.x; asm volatile("" : "+v"(tid_)); const int lane = tid_ & 63;
    const bf16_t* Y = (const bf16_t*)(p.ws + WS_XN);
    f32x4 g[4];
#pragma unroll
    for (int i = 0; i < 4; ++i) g[i] = *(const f32x4*)(p.final_g + (lane + 64 * i) * 4);
    if (first_wave < 0) return;
    for (int r0 = row_begin + first_wave; r0 < row_end; r0 += 4 * nw) {
        f32x4 hv[4][4]; float s[4] = {0.f, 0.f, 0.f, 0.f};
#pragma unroll
        for (int j = 0; j < 4; ++j) { const int row = r0 + j * nw; if (row < row_end) {
            const float* xr = row < MPR ? p.x_prompt + (size_t)row * D : p.x_sample + (size_t)(row - MPR) * D; const bf16_t* yr = Y + (size_t)row * D;
#pragma unroll
            for (int i = 0; i < 4; ++i) { const int c = (lane + 64 * i) * 4; const f32x4 x = __builtin_nontemporal_load((const f32x4*)(xr + c)); const u32x2 y = __builtin_nontemporal_load((const u32x2*)(yr + c));
                hv[j][i] = x + (f32x4){bflo(y.x), bfhi(y.x), bflo(y.y), bfhi(y.y)}; } } }
#pragma unroll
        for (int j = 0; j < 4; ++j) { const int row = r0 + j * nw; if (row < row_end) {
#pragma unroll
            for (int i = 0; i < 4; ++i) s[j] += hv[j][i][0] * hv[j][i][0] + hv[j][i][1] * hv[j][i][1] + hv[j][i][2] * hv[j][i][2] + hv[j][i][3] * hv[j][i][3];
#pragma unroll
            for (int o = 32; o >= 1; o >>= 1) s[j] += __shfl_xor(s[j], o);
            const float rs = rsqrtf(s[j] * (1.0f / 1024.0f) + 1e-6f); float* orow = p.out + (size_t)row * D;
#pragma unroll
            for (int i = 0; i < 4; ++i) __builtin_nontemporal_store(hv[j][i] * rs * g[i], (f32x4*)(orow + (lane + 64 * i) * 4)); } }
    }
}

__global__ void __launch_bounds__(512, 2) fwd_megakernel(Params p) {
    extern __shared__ __attribute__((aligned(16))) unsigned char lds[];
    cg::grid_group grid = cg::this_grid();
    if (threadIdx.x == 0) { *(volatile unsigned*)(lds + LD_XB) = 0u; *(volatile unsigned*)(lds + LD_XB + 4) = 0u; *(volatile unsigned*)(lds + LD_XB + 8) = 0u; }
    __syncthreads();
    const XcdBarrier xb = xcd_barrier_post((unsigned*)(p.ws + WS_BAR), (volatile LAS unsigned*)(lds + LD_XB));
#ifndef REP0
#define REP0 1
#endif
#ifndef REP1
#define REP1 1
#endif
#ifndef REP2
#define REP2 1
#endif
#ifndef REPS
#define REPS 0
#endif
#ifndef REPALL
#define REPALL 1
#endif
#ifndef SKIPM
#define SKIPM 0
#endif
#define RUNPH(bit) (fwd == 0 || !((SKIPM >> (bit)) & 1))
#pragma unroll 1
    for (int fwd = 0; fwd < REPALL; ++fwd) {
    if (fwd) xcd_barrier(xb);
    for (int rep = 0; rep < REP0; ++rep) phase0(p, lds);
    if (p.use_cg_sync) grid.sync(); else xcd_barrier(xb);
    for (int rep = 0; rep < REPS; ++rep) grid.sync();
    for (int rep = 0; rep < REP1; ++rep)
    { pg8::Gemm g; g.A = (const bf16_t*)(p.ws + WS_XN); g.Bt = (const bf16_t*)(p.ws + WS_W1); g.M = MROWS; g.N = NP; g.K = D;
      pg8::StaticOrder S; S.init(g.M, g.N, (int)gridDim.x, (int)blockIdx.x);
      EpiP E; E.P = (bf16_t*)(p.ws + WS_P);

#ifndef NO_GEMM
pg8::gemm_phase<EpiP, pg8::StaticOrder, false>((PG8_LAS unsigned char*)lds, g, S, E, nullptr);
#endif
 }
    xcd_barrier(xb);
    for (int rep = 0; rep < REP2; ++rep) phase2(p, lds);
#ifndef REP2B
#define REP2B 1
#endif
#ifndef REP3
#define REP3 1
#endif
#ifndef REP4
#define REP4 1
#endif
    for (int rep = 0; rep < REP2B; ++rep) phase2b(p, lds, (fwd > 0 && ((SKIPM >> 6) & 1)) ? 1 : 0);
    xcd_barrier(xb);
    const int nbk = (int)gridDim.x, bidk = (int)blockIdx.x, widk = (int)(threadIdx.x >> 6);
    const bool two = nbk > 16;
    if (RUNPH(4)) { pg8::Gemm g; g.A = (const bf16_t*)(p.ws + WS_YC); g.Bt = (const bf16_t*)(p.ws + WS_W2); g.M = two ? MPR : MTOK; g.N = D; g.K = D;
      pg8::StaticOrder S; S.init(g.M, g.N, nbk, bidk);
      pg8::EpiBf16<0> E; E.O = (bf16_t*)(p.ws + WS_XN); E.ldc = D; E.bias = nullptr; E.split_cols = 0; E.split_stride = 0;
#ifndef NO_GEMM
      pg8::gemm_phase<pg8::EpiBf16<0>, pg8::StaticOrder, false>((PG8_LAS unsigned char*)lds, g, S, E, nullptr);
#endif
    }
    xcd_barrier(xb);
    if (RUNPH(5)) {
    if (two) {
        pg8::Gemm g; g.A = (const bf16_t*)(p.ws + WS_YC) + (size_t)MPR * D; g.Bt = (const bf16_t*)(p.ws + WS_W2); g.M = MTOK - MPR; g.N = D; g.K = D;
        pg8::StaticOrder S; S.init(g.M, g.N, nbk, bidk);
        pg8::EpiBf16<0> E; E.O = (bf16_t*)(p.ws + WS_XN) + (size_t)MPR * D; E.ldc = D; E.bias = nullptr; E.split_cols = 0; E.split_stride = 0;
#ifndef NO_GEMM
        pg8::gemm_phase<pg8::EpiBf16<0>, pg8::StaticOrder, false>((PG8_LAS unsigned char*)lds, g, S, E, nullptr);
#endif
    }
    int r_begin = 0, r_end = two ? MPR : MTOK, fw = two ? (bidk - 16) * 8 + widk : bidk * 8 + widk, nwv = two ? (nbk - 16) * 8 : nbk * 8;
    if (two && bidk < 16) {
        pg8::StaticOrder S; S.init(MTOK - MPR, D, nbk, bidk); pg8::Unit u; (void)S.next(0, u);
        group_barrier((unsigned*)(p.ws + WS_BAR) + 3584 + 64 * u.pm, 4u * (unsigned)(fwd + 1));
        r_begin = MPR + u.pm * 256 + u.pn * 64; r_end = r_begin + 64; fw = widk; nwv = 8;
    }
    phase4(p, r_begin, r_end, fw, nwv);
    }
    }
}

extern "C" void kernel_launch(void* const* d_in, const int* in_sizes, int n_in, void* d_out, int out_size, void* d_ws, size_t ws_size, hipStream_t stream) {
    static int grid_blocks = 0;
    if (!grid_blocks) {
        int dev = 0, cus = 0, per_cu = 0;
        hipGetDevice(&dev); hipDeviceGetAttribute(&cus, hipDeviceAttributeMultiprocessorCount, dev);
        hipFuncSetAttribute((const void*)fwd_megakernel, hipFuncAttributeMaxDynamicSharedMemorySize, LDS_BYTES);
        hipOccupancyMaxActiveBlocksPerMultiprocessor(&per_cu, (const void*)fwd_megakernel, 512, LDS_BYTES);
        if (per_cu < 1) per_cu = 1;
        grid_blocks = cus * per_cu;
        if (ws_size < WS_END || n_in != 20) fprintf(stderr, "kernel_launch: unexpected sizes ws %zu n_in %d\n", ws_size, n_in);
    }
    (void)hipMemsetAsync((unsigned char*)d_ws + WS_BAR, 0, 65536, stream);
    Params p{};
    const float** pp = (const float**)&p;
    for (int i = 0; i < 20; ++i) pp[i] = (const float*)d_in[i];
    p.out = (float*)d_out; p.ws = (unsigned char*)d_ws;
    void* args[] = {&p};
    hipError_t e = hipLaunchCooperativeKernel((const void*)fwd_megakernel, dim3(grid_blocks), dim3(512), args, LDS_BYTES, stream);
    if (e != hipSuccess) fprintf(stderr, "cooperative launch failed: %s (grid %d)\n", hipGetErrorString(e), grid_blocks);
}
```

```cpp
#include <hip/hip_runtime.h>
#include <hip/hip_cooperative_groups.h>
#include <cstdio>
namespace cg = cooperative_groups;
namespace pg8 {
#define PG8_LAS __attribute__((address_space(3)))
typedef unsigned short bf16_t;
typedef short bf16x8 __attribute__((ext_vector_type(8)));
typedef float f32x4 __attribute__((ext_vector_type(4)));
typedef unsigned u32x4 __attribute__((ext_vector_type(4)));
constexpr int BM = 256, BK = 64, HALF = 128, HTB = HALF * BK * 2  , STAGE_BYTES = 8 * HTB, NXCD = 8, WGM = 8;

__host__ __device__ __forceinline__ int lds_byte(int r, int c) { const int st = (r >> 4) * 2 + (c >> 5), rr = r & 15, cc = c & 31, ob = rr * 64 + cc * 2; return st * 1024 + (ob ^ (((ob >> 9) & 1) << 5)); }
__host__ __device__ __forceinline__ void stage_rc(int b, int& R, int& C) { const int st = b / 1024, sb = b % 1024, swz = sb ^ (((sb >> 9) & 1) << 5); R = (st >> 1) * 16 + swz / 64; C = (st & 1) * 32 + (swz % 64) / 2; }
__host__ __device__ __forceinline__ int perm32(int rho) { const int n = rho >> 4, i = rho & 15; return 8 * (i >> 2) + 4 * n + (i & 3); }

struct Unit { int pm, pn; };
struct Gemm { const bf16_t* A; const bf16_t* Bt; int M, N, K; };

struct StaticOrder {
    int nM, nN, nwg, G, c;
    __host__ __device__ void init(int M, int N, int G_, int c_) { nM = M / BM; nN = N / BM; nwg = nM * nN; G = G_; c = c_; }
    __host__ __device__ bool next(int i, Unit& u) const {
        const long L = (long)i * G + c; if (L >= nwg) return false;
        int wgid = (int)L; { const int q = nwg / NXCD, r = nwg % NXCD, xcd = wgid % NXCD, off = wgid / NXCD; wgid = (xcd < r ? xcd * (q + 1) : r * (q + 1) + (xcd - r) * q) + off; }
        const int nig = WGM * nN, gid = wgid / nig, fm = gid * WGM, gsz = (nM - fm) < WGM ? (nM - fm) : WGM;
        u.pm = fm + ((wgid % nig) % gsz); u.pn = (wgid % nig) / gsz; return true;
    }
    __device__ __forceinline__ void a_ready(const Unit&) const {}
    __device__ __forceinline__ void done(const Unit&) const {}
};
struct CountedOrder : StaticOrder {
    const unsigned* ready; unsigned need; unsigned* tmo;
    __device__ __forceinline__ void a_ready(const Unit& u) const {
        if (threadIdx.x < 64) {
            const unsigned long long t0 = __builtin_amdgcn_s_memrealtime(); unsigned polls = 0;
            while ((unsigned)__builtin_amdgcn_readfirstlane(__hip_atomic_load(ready + 64 * u.pm, __ATOMIC_RELAXED, __HIP_MEMORY_SCOPE_AGENT)) < need) {
                if ((++polls & 255u) == 0u && __builtin_amdgcn_readfirstlane(__hip_atomic_load(tmo, __ATOMIC_RELAXED, __HIP_MEMORY_SCOPE_AGENT)) != 0u) break;
                if (__builtin_amdgcn_s_memrealtime() - t0 > 2000000ull) {
                    if (threadIdx.x == 0) { unsigned expect = 0u; __hip_atomic_compare_exchange_strong(tmo + 1, &expect, 0x600u | (unsigned)(u.pm & 0xff), __ATOMIC_RELAXED, __ATOMIC_RELAXED, __HIP_MEMORY_SCOPE_AGENT); __hip_atomic_store(tmo, 1u, __ATOMIC_RELAXED, __HIP_MEMORY_SCOPE_AGENT); }
                    break; }
                __builtin_amdgcn_s_sleep(2); }
            __builtin_amdgcn_fence(__ATOMIC_ACQUIRE, "agent");
            asm volatile("s_waitcnt vmcnt(0)" ::: "memory");
        }
#if !defined(BROKEN_HOOK_NO_BARRIER)
        asm volatile("" ::: "memory"); __builtin_amdgcn_s_barrier(); asm volatile("" ::: "memory");
#endif
    }
};

__device__ __forceinline__ unsigned cvt_pk_bf16(float lo, float hi) { unsigned r; asm volatile("v_cvt_pk_bf16_f32 %0, %1, %2" : "=v"(r) : "v"(lo), "v"(hi)); return r; }
typedef float f32x2 __attribute__((ext_vector_type(2)));
__device__ __forceinline__ f32x2 gelu_pk(f32x2 v) {
    const f32x2 av = __builtin_elementwise_abs(v), d = av * 0.2316418882f + 1.0f;
    f32x2 t; t.x = __builtin_amdgcn_rcpf(d.x); t.y = __builtin_amdgcn_rcpf(d.y);
    f32x2 q = t * 0.5307027145f + (-0.7265760135f); q = q * t + 0.7107068705f; q = q * t + (-0.142248368f); q = q * t + 0.127414796f; q = q * t;
    const f32x2 s = (v * v) * (-0.72134752044f);
    f32x2 e; e.x = __builtin_amdgcn_exp2f(s.x); e.y = __builtin_amdgcn_exp2f(s.y);
    const f32x2 m = v * (q * e), r = v - m;
    f32x2 o; o.x = v.x < 0.f ? m.x : r.x; o.y = v.y < 0.f ? m.y : r.y; return o;
}

struct EpiF32 {
    static constexpr bool PERM = false, AFTER_DRAIN = false;
    float* C; int ldc; const float* bias;
    __device__ __forceinline__ void operator()(const f32x4 (&acc)[2][2][4][2], const Unit& u, int wr, int wc, int fr, int fq) const {
        const int row0 = u.pm * BM + wr * 64 + fr, col0 = u.pn * BM + wc * 32 + 4 * fq;
        f32x4 bv[2][2];
#pragma unroll
        for (int bj = 0; bj < 2; ++bj)
#pragma unroll
            for (int n = 0; n < 2; ++n) bv[bj][n] = bias ? *(const f32x4*)(bias + col0 + bj * HALF + n * 16) : (f32x4){0.f, 0.f, 0.f, 0.f};
#pragma unroll
        for (int ai = 0; ai < 2; ++ai)
#pragma unroll
            for (int m = 0; m < 4; ++m) { float* rowp = C + (size_t)(row0 + ai * HALF + m * 16) * ldc + col0;
#pragma unroll
                for (int bj = 0; bj < 2; ++bj)
#pragma unroll
                    for (int n = 0; n < 2; ++n) *(f32x4*)(rowp + bj * HALF + n * 16) = acc[ai][bj][m][n] + bv[bj][n]; }
    }
};
template <int ACT  > struct EpiBf16 {
    static constexpr bool PERM = true, AFTER_DRAIN = false;
    bf16_t* O; int ldc; const float* bias; int split_cols; size_t split_stride;
    __device__ __forceinline__ void operator()(const f32x4 (&acc)[2][2][4][2], const Unit& u, int wr, int wc, int fr, int fq) const {
        const int row0 = u.pm * BM + wr * 64 + fr; int colt = u.pn * BM; bf16_t* base = O;
        if (split_cols) { const int t = colt / split_cols; base += (size_t)t * split_stride; colt -= t * split_cols; }
        const int col0 = colt + wc * 32 + 8 * fq, bcol0 = u.pn * BM + wc * 32 + 8 * fq;
        f32x4 bv[2][2];
#pragma unroll
        for (int bj = 0; bj < 2; ++bj)
#pragma unroll
            for (int n = 0; n < 2; ++n) bv[bj][n] = bias ? *(const f32x4*)(bias + bcol0 + bj * HALF + 4 * n) : (f32x4){0.f, 0.f, 0.f, 0.f};
#pragma unroll
        for (int ai = 0; ai < 2; ++ai)
#pragma unroll
            for (int m = 0; m < 4; ++m) { bf16_t* rowp = base + (size_t)(row0 + ai * HALF + m * 16) * ldc + col0;
#pragma unroll
                for (int bj = 0; bj < 2; ++bj) { f32x4 v0 = acc[ai][bj][m][0] + bv[bj][0], v1 = acc[ai][bj][m][1] + bv[bj][1];
                    if (ACT == 1) { f32x2 a = gelu_pk((f32x2){v0[0], v0[1]}), b = gelu_pk((f32x2){v0[2], v0[3]}), c = gelu_pk((f32x2){v1[0], v1[1]}), d = gelu_pk((f32x2){v1[2], v1[3]});
                        v0 = (f32x4){a.x, a.y, b.x, b.y}; v1 = (f32x4){c.x, c.y, d.x, d.y}; }
                    if (ACT == 2) {
#pragma unroll
                        for (int j = 0; j < 4; ++j) { v0[j] = 0.5f * v0[j] * (1.0f + erff(v0[j] * 0.70710678f)); v1[j] = 0.5f * v1[j] * (1.0f + erff(v1[j] * 0.70710678f)); } }
                    u32x4 w; w.x = cvt_pk_bf16(v0[0], v0[1]); w.y = cvt_pk_bf16(v0[2], v0[3]); w.z = cvt_pk_bf16(v1[0], v1[1]); w.w = cvt_pk_bf16(v1[2], v1[3]);
                    *(u32x4*)(rowp + bj * HALF) = w; } }
    }
};
template <class Epi, class Sched, bool STAMP = false>
__device__ __forceinline__ void gemm_phase(PG8_LAS unsigned char* lds, const Gemm g, const Sched& S, const Epi& E, unsigned long long* stamps) {
    int tid_ = threadIdx.x; asm volatile("" : "+v"(tid_));
    const int tid = tid_, wid = __builtin_amdgcn_readfirstlane(tid >> 6), lane = tid & 63, wr = wid >> 2, wc = wid & 3, fr = lane & 15, fq = lane >> 4;
    const int K = g.K, nt = K / BK;
    int ts_lo = 0, ts_hi = 0, nts = 0; const unsigned long long rt_entry = STAMP ? (unsigned long long)wall_clock64() : 0ull;
#define PG8_STAMP() do { if (STAMP && wid == 0 && nts < 64) { const unsigned long long _c = (unsigned long long)clock64(); \
        ts_lo = (lane == nts) ? (int)(unsigned)_c : ts_lo; ts_hi = (lane == nts) ? (int)(unsigned)(_c >> 32) : ts_hi; ++nts; } } while (0)
    PG8_STAMP();
    unsigned voffA[2], voffB[2];
#pragma unroll
    for (int i = 0; i < 2; ++i) { int R, C; stage_rc(tid * 16 + i * 8192, R, C); const int Rb = Epi::PERM ? ((R & ~31) + perm32(R & 31)) : R;
        voffA[i] = (unsigned)(R * K + C) * 2u; voffB[i] = (unsigned)(Rb * K + C) * 2u; }
    const size_t kstep = (size_t)(BK * 2);
    const size_t hstep = (size_t)HALF * K * 2;
    const size_t tstep = 2 * hstep;
    const unsigned ldsw = (unsigned)wid * 1024u;
    const int aoff = lds_byte(wr * 64 + fr, fq * 8), boff = lds_byte(wc * 32 + fr, fq * 8);
#define PG8_SA(b, h) (((b) * 2 + (h)) * HTB)
#define PG8_SB(b, h) ((4 + (b) * 2 + (h)) * HTB)
#define PG8_STAGE(bufoff, gbase, voff) do { _Pragma("unroll") for (int _i = 0; _i < 2; ++_i) \
        __builtin_amdgcn_global_load_lds((const unsigned*)((const char*)(gbase) + (voff)[_i]), (PG8_LAS unsigned*)(lds + (bufoff) + ldsw + _i * 8192), 16, 0, 0); } while (0)
#define PG8_LDA(dst, b, h) do { _Pragma("unroll") for (int m = 0; m < 4; ++m) _Pragma("unroll") for (int k = 0; k < 2; ++k) dst[m][k] = *(const PG8_LAS bf16x8*)(lds + PG8_SA(b, h) + aoff + m * 2048 + k * 1024); } while (0)
#define PG8_LDB(dst, b, h) do { _Pragma("unroll") for (int n = 0; n < 2; ++n) _Pragma("unroll") for (int k = 0; k < 2; ++k) dst[n][k] = *(const PG8_LAS bf16x8*)(lds + PG8_SB(b, h) + boff + n * 2048 + k * 1024); } while (0)
#define PG8_MMA(ai, bj, At, Bt) do { __builtin_amdgcn_s_setprio(1); _Pragma("unroll") for (int m = 0; m < 4; ++m) _Pragma("unroll") for (int n = 0; n < 2; ++n) _Pragma("unroll") for (int k = 0; k < 2; ++k) \
        acc[ai][bj][m][n] = __builtin_amdgcn_mfma_f32_16x16x32_bf16(Bt[n][k], At[m][k], acc[ai][bj][m][n], 0, 0, 0); __builtin_amdgcn_s_setprio(0); } while (0)
#define PG8_WAIT_V(n) asm volatile("s_waitcnt vmcnt(" #n ")" ::: "memory")
#define PG8_WAIT_L(n) asm volatile("s_waitcnt lgkmcnt(" #n ")" ::: "memory")
#define PG8_BAR __builtin_amdgcn_s_barrier()
#define PG8_SCHED __builtin_amdgcn_sched_barrier(0)
    Unit cur, nxt; int ui = 0;
    if (!S.next(0, cur)) return;
    f32x4 acc[2][2][4][2];
#pragma unroll
    for (int a = 0; a < 2; ++a)
#pragma unroll
        for (int b = 0; b < 2; ++b)
#pragma unroll
            for (int m = 0; m < 4; ++m)
#pragma unroll
                for (int n = 0; n < 2; ++n) acc[a][b][m][n] = (f32x4){0.f, 0.f, 0.f, 0.f};
    bf16x8 At[4][2], B0[2][2], B1[2][2];
    const char* cA = (const char*)g.A + (size_t)cur.pm * tstep; const char* cB = (const char*)g.Bt + (size_t)cur.pn * tstep;
    S.a_ready(cur);
    PG8_STAGE(PG8_SB(0, 0), cB, voffB); PG8_STAGE(PG8_SA(0, 0), cA, voffA); PG8_STAGE(PG8_SB(0, 1), cB + hstep, voffB); PG8_STAGE(PG8_SA(0, 1), cA + hstep, voffA);
    if (wr == 1) PG8_BAR;
    PG8_WAIT_V(4); PG8_BAR;
    PG8_STAGE(PG8_SB(1, 0), cB + kstep, voffB); PG8_STAGE(PG8_SA(1, 0), cA + kstep, voffA); PG8_STAGE(PG8_SB(1, 1), cB + hstep + kstep, voffB);
    PG8_WAIT_V(6); PG8_BAR;
    PG8_STAMP();
    for (;;) {
        const bool has_next = S.next(ui + 1, nxt);
        const char* nA = has_next ? (const char*)g.A + (size_t)nxt.pm * tstep : cA; const char* nB = has_next ? (const char*)g.Bt + (size_t)nxt.pn * tstep : cB;
        for (int t = 0; t < nt; t += 2) {
            const bool last = (t == nt - 2);
            const char* a1 = cA + (size_t)(t + 1) * kstep;
            const char* a2 = last ? nA : cA + (size_t)(t + 2) * kstep; const char* b2 = last ? nB : cB + (size_t)(t + 2) * kstep;
            const char* a3 = a2 + kstep; const char* b3 = b2 + kstep;
            if (last && has_next) S.a_ready(nxt);
            PG8_LDB(B0, 0, 0); PG8_SCHED; PG8_LDA(At, 0, 0); PG8_STAGE(PG8_SA(1, 1), a1 + hstep, voffA);
            PG8_WAIT_L(8); PG8_BAR; PG8_WAIT_L(0); PG8_MMA(0, 0, At, B0); PG8_BAR; PG8_SCHED;
            PG8_LDB(B1, 0, 1); PG8_STAGE(PG8_SB(0, 0), b2, voffB);
            PG8_BAR; PG8_WAIT_L(0); PG8_MMA(0, 1, At, B1); PG8_BAR;
            PG8_LDA(At, 0, 1); PG8_STAGE(PG8_SA(0, 0), a2, voffA);
            PG8_BAR; PG8_WAIT_L(0); PG8_MMA(1, 0, At, B0); PG8_BAR; PG8_SCHED;
            PG8_STAGE(PG8_SB(0, 1), b2 + hstep, voffB);
            PG8_WAIT_V(6); PG8_BAR; PG8_MMA(1, 1, At, B1); PG8_BAR;
            PG8_LDB(B0, 1, 0); PG8_SCHED; PG8_LDA(At, 1, 0); PG8_STAGE(PG8_SA(0, 1), a2 + hstep, voffA);
            PG8_WAIT_L(8); PG8_BAR; PG8_WAIT_L(0); PG8_MMA(0, 0, At, B0); PG8_BAR; PG8_SCHED;
            PG8_LDB(B1, 1, 1); PG8_STAGE(PG8_SB(1, 0), b3, voffB);
            PG8_BAR; PG8_WAIT_L(0); PG8_MMA(0, 1, At, B1); PG8_BAR;
            PG8_LDA(At, 1, 1); PG8_STAGE(PG8_SA(1, 0), a3, voffA);
            PG8_BAR; PG8_WAIT_L(0); PG8_MMA(1, 0, At, B0); PG8_BAR; PG8_SCHED;
            PG8_STAGE(PG8_SB(1, 1), b3 + hstep, voffB);
            PG8_WAIT_V(6); PG8_BAR; PG8_MMA(1, 1, At, B1); PG8_BAR;
        }
        PG8_STAMP();
        if constexpr (!Epi::AFTER_DRAIN) { E(acc, cur, wr, wc, fr, fq); S.done(cur); }
        PG8_STAMP();
        if (!has_next) break;
#pragma unroll
        for (int a = 0; a < 2; ++a)
#pragma unroll
            for (int b = 0; b < 2; ++b)
#pragma unroll
                for (int m = 0; m < 4; ++m)
#pragma unroll
                    for (int n = 0; n < 2; ++n) acc[a][b][m][n] = (f32x4){0.f, 0.f, 0.f, 0.f};
        cur = nxt; cA = nA; cB = nB; ++ui;
    }
    PG8_WAIT_V(0);
    if (wr == 0) PG8_BAR;
    PG8_BAR;
    if constexpr (Epi::AFTER_DRAIN) { E.fused(acc, cur, wr, wc, fr, fq, lds, wid, lane); S.done(cur); }
    PG8_STAMP();
    if (STAMP && wid == 0) { stamps[lane] = lane < nts ? (((unsigned long long)(unsigned)ts_hi << 32) | (unsigned)ts_lo) : 0ull;
        if (lane == 62) stamps[62] = rt_entry; if (lane == 63) stamps[63] = (unsigned long long)wall_clock64(); }
#undef PG8_STAMP
#undef PG8_SA
#undef PG8_SB
#undef PG8_STAGE
#undef PG8_LDA
#undef PG8_LDB
#undef PG8_MMA
#undef PG8_WAIT_V
#undef PG8_WAIT_L
#undef PG8_BAR
#undef PG8_SCHED
}
}
using pg8::bf16_t; using pg8::f32x4;
typedef __bf16 bf16x2_n __attribute__((ext_vector_type(2))); typedef float f32x2_n __attribute__((ext_vector_type(2)));
__device__ __forceinline__ unsigned cvt_pk_bf16(float lo, float hi) { const f32x2_n v = {lo, hi}; return __builtin_bit_cast(unsigned, __builtin_convertvector(v, bf16x2_n)); }
typedef unsigned u32x2 __attribute__((ext_vector_type(2)));
typedef unsigned u32x4v __attribute__((ext_vector_type(4)));
constexpr int D = 1024, MPR = 16384, MTOK = 17408, MROWS = 17664, INC = 4224, NP = 4352, SEQ = 2048, DSEQ = 8, NDB = 128, NH = 8;
constexpr int RC = 2048;
constexpr size_t OFF_YS = (size_t)MPR * D, OFF_CONVP = OFF_YS + 1024 * 1024, OFF_SHIFTP = OFF_CONVP + 8192, OFF_WKVP = OFF_SHIFTP + 8192,
                 OFF_CONVS = OFF_WKVP + 262144, OFF_SHIFTS = OFF_CONVS + 131072, OFF_WKVS = OFF_SHIFTS + 131072;
constexpr size_t WS_XN = 0, WS_W1 = WS_XN + (size_t)MROWS * D * 2, WS_W2 = WS_W1 + (size_t)NP * D * 2, WS_P = WS_W2 + (size_t)D * D * 2,
                 WS_YC = WS_P + (size_t)MROWS * NP * 2, WS_SS = WS_YC + (size_t)MTOK * D * 2, WS_BAR = WS_SS + (size_t)MTOK * 4, WS_CHC = WS_BAR + 16384, WS_RHO = WS_BAR + 65536, WS_MN = WS_RHO + (size_t)MPR * 512 * 2, WS_BON = WS_MN + (size_t)256 * 2 * 4096 * 4, WS_END = WS_BON + (size_t)MPR * 8 * 4;
constexpr size_t WS_OZ = WS_XN;
static_assert((size_t)MPR * 512 * 4 <= (size_t)MROWS * D * 2 && WS_END <= 268435456, "workspace map");
constexpr int LDS_BYTES = 153872;

struct Params {
    const float *x_prompt, *x_sample, *state_conv, *state_shift, *state_wkv, *norm_g, *w_in, *mu_shift, *conv_w, *w_dec2, *w0, *w_a2, *a0, *k_k, *k_a, *r_k, *lnx_g, *lnx_b, *w_out, *final_g;
    float* out; unsigned char* ws;
    int use_cg_sync, pad_;
};

__device__ __forceinline__ float bf2f(unsigned short b) { return __uint_as_float(((unsigned)b) << 16); }
__device__ __forceinline__ float bflo(unsigned w) { return __uint_as_float(w << 16); }
__device__ __forceinline__ float bfhi(unsigned w) { return __uint_as_float(w & 0xffff0000u); }
__device__ __forceinline__ float sigmoidf_(float x) { return __builtin_amdgcn_rcpf(1.0f + __expf(-x)); }
__device__ __forceinline__ float siluf_(float x) { return x * __builtin_amdgcn_rcpf(1.0f + __expf(-x)); }

#define XB_TMO      128
#define XB_XCNT(j)  (256  + 64 * (j))
#define XB_XSUB(j)  (1280 + 64 * (j))
#define XB_XGEN(j)  (2304 + 64 * (j))
#define XB_TOP      3328
#define XB_TOPGEN   3392
#define XCD_BAR_WORDS 3456
#define XB_SPIN_CAP (1u << 18)
#define LAS __attribute__((address_space(3)))

__device__ __forceinline__ unsigned xb_ld(unsigned* p)              { return __hip_atomic_load(p, __ATOMIC_RELAXED, __HIP_MEMORY_SCOPE_AGENT); }
__device__ __forceinline__ unsigned xb_add(unsigned* p, unsigned v) { return __hip_atomic_fetch_add(p, v, __ATOMIC_RELAXED, __HIP_MEMORY_SCOPE_AGENT); }
__device__ __forceinline__ unsigned xb_xcc_id() { return (unsigned)__builtin_amdgcn_s_getreg((3 << 11) | 20) & 0xFu; }
#define XB_SPIN(cond, bar) do { unsigned _sp = 0; while (cond) { __builtin_amdgcn_s_sleep(1); \
    if ((++_sp & 255u) == 0u) { if (xb_ld(&(bar)[XB_TMO])) break; if (_sp > XB_SPIN_CAP) { atomicAdd(&(bar)[XB_TMO], 1u); break; } } } } while (0)

struct XcdBarrier {
    unsigned* bar; unsigned x;
    volatile LAS unsigned* st;
};

__device__ __forceinline__ XcdBarrier xcd_barrier_post(unsigned* bar, volatile LAS unsigned* st) {
    XcdBarrier b; b.bar = bar; b.x = xb_xcc_id(); b.st = st;
    if (threadIdx.x == 0) (void)xb_add(&bar[XB_XCNT(b.x)], 1u);
    return b;
}
__device__ __forceinline__ void xcd_barrier_complete(unsigned* bar, unsigned x, unsigned& nloc, unsigned& nx) {
    const unsigned G = gridDim.x * gridDim.y * gridDim.z;
    unsigned sum, cnt, mine, sp = 0u;
    for (;;) {
        sum = 0u; cnt = 0u; mine = 0u;
#pragma unroll
        for (unsigned j = 0; j < 16; ++j) { const unsigned c = xb_ld(&bar[XB_XCNT(j)]); sum += c; cnt += (c > 0u) ? 1u : 0u; mine = (j == x) ? c : mine; }
        if (sum == G) break;
        __builtin_amdgcn_s_sleep(1);
        if ((++sp & 255u) == 0u) { if (xb_ld(&bar[XB_TMO])) break; if (sp > XB_SPIN_CAP) { atomicAdd(&bar[XB_TMO], 1u); break; } }
    }
    nloc = mine > 0u ? mine : 1u; nx = cnt > 0u ? cnt : 1u;
}

__device__ __forceinline__ void xcd_barrier(const XcdBarrier& b) {
    asm volatile("s_waitcnt vmcnt(0)" ::: "memory");
    __syncthreads();
    if (threadIdx.x == 0) {
        unsigned* bar = b.bar;
        __builtin_amdgcn_s_waitcnt(0);
        unsigned nloc = b.st[0], nx = b.st[1];
        if (nloc == 0u) { xcd_barrier_complete(bar, b.x, nloc, nx); b.st[0] = nloc; b.st[1] = nx; }
        const unsigned old = xb_add(&bar[XB_XSUB(b.x)], 1u);
        const unsigned gen = old / nloc;
        if (old + 1u == (gen + 1u) * nloc) {
            __builtin_amdgcn_fence(__ATOMIC_RELEASE, "agent");
            asm volatile("s_waitcnt vmcnt(0)" ::: "memory");
            const unsigned og = xb_add(&bar[XB_TOP], 1u);
            const unsigned tg = og / nx;
            if (og + 1u == (tg + 1u) * nx) xb_add(&bar[XB_TOPGEN], 1u);
            else XB_SPIN(xb_ld(&bar[XB_TOPGEN]) == tg, bar);
            __builtin_amdgcn_fence(__ATOMIC_ACQUIRE, "agent");
            xb_add(&bar[XB_XGEN(b.x)], 1u);
            asm volatile("s_waitcnt vmcnt(0)" ::: "memory");
        } else {
            XB_SPIN(xb_ld(&bar[XB_XGEN(b.x)]) == gen, bar);
            __builtin_amdgcn_fence(__ATOMIC_ACQUIRE, "agent");
            asm volatile("s_waitcnt vmcnt(0)" ::: "memory");
        }
    }
    __syncthreads();
}

struct EpiP {
    static constexpr bool PERM = true, AFTER_DRAIN = false;
    bf16_t* P;
    __device__ __forceinline__ void operator()(const f32x4 (&acc)[2][2][4][2], const pg8::Unit& u, int wr, int wc, int fr, int fq) const {
        const int row0 = u.pm * 256 + wr * 64 + fr;
        if (u.pn < 8) {
            const int ch0 = 64 * u.pn + 16 * wc + 4 * fq;
#pragma unroll
            for (int ai = 0; ai < 2; ++ai)
#pragma unroll
                for (int m = 0; m < 4; ++m) { bf16_t* rowp = P + (size_t)(row0 + ai * 128 + m * 16) * NP + ch0;
                    const f32x4 hh = acc[ai][0][m][0], cc = acc[ai][0][m][1], bb = acc[ai][1][m][0], gg = acc[ai][1][m][1];
                    const f32x4 uu = cc * hh; f32x4 qq;
#pragma unroll
                    for (int e = 0; e < 4; ++e) qq[e] = bb[e] * gg[e] * __builtin_amdgcn_rcpf(1.0f + __expf(-gg[e]));
                    u32x2 w0; w0.x = cvt_pk_bf16(uu[0], uu[1]); w0.y = cvt_pk_bf16(uu[2], uu[3]); u32x2 w1; w1.x = cvt_pk_bf16(qq[0], qq[1]); w1.y = cvt_pk_bf16(qq[2], qq[3]);
                    *(u32x2*)rowp = w0; *(u32x2*)(rowp + 512) = w1; }
        } else {
            const int col0 = u.pn * 256 + wc * 32 + 8 * fq;
#pragma unroll
            for (int ai = 0; ai < 2; ++ai)
#pragma unroll
                for (int m = 0; m < 4; ++m) { bf16_t* rowp = P + (size_t)(row0 + ai * 128 + m * 16) * NP + col0;
#pragma unroll
                    for (int bj = 0; bj < 2; ++bj) { const f32x4 v0 = acc[ai][bj][m][0], v1 = acc[ai][bj][m][1];
                        u32x4v w; w.x = cvt_pk_bf16(v0[0], v0[1]); w.y = cvt_pk_bf16(v0[2], v0[3]); w.z = cvt_pk_bf16(v1[0], v1[1]); w.w = cvt_pk_bf16(v1[2], v1[3]);
                        *(u32x4v*)(rowp + bj * 128) = w; } }
        }
    }
};
__device__ void phase0(const Params& p, unsigned char* lds) {
    int tid_ = threadIdx.x; asm volatile("" : "+v"(tid_)); const int tid = tid_, nb = gridDim.x, bid = blockIdx.x, wid = tid >> 6, lane = tid & 63;
    float* tile = (float*)lds;
    bf16_t* W1 = (bf16_t*)(p.ws + WS_W1); bf16_t* W2 = (bf16_t*)(p.ws + WS_W2); bf16_t* XN = (bf16_t*)(p.ws + WS_XN); float* SS = (float*)(p.ws + WS_SS);
    for (int it0 = bid; it0 < 1088 + 256; it0 += 2 * nb) {
        float vals[2][8];
#pragma unroll
        for (int u = 0; u < 2; ++u) { const int it = it0 + u * nb;
            if (it < 1088 + 256) { const float* src; int ncs, n0, k0;
                if (it < 1088) { const int kt = it / 68, nt = it % 68; src = p.w_in; ncs = INC; n0 = nt * 64; k0 = kt * 64; }
                else { const int j = it - 1088, kt = j >> 4, nt = j & 15; src = p.w_out; ncs = D; n0 = nt * 64; k0 = kt * 64; }
#pragma unroll
                for (int e = 0; e < 8; ++e) { const int idx = e * 512 + tid, kk = idx >> 6, nn = idx & 63, n = n0 + nn; vals[u][e] = (n < ncs) ? src[(size_t)(k0 + kk) * ncs + n] : 0.f; } } }
#pragma unroll
        for (int u = 0; u < 2; ++u)
#pragma unroll
            for (int e = 0; e < 8; ++e) { const int idx = e * 512 + tid, kk = idx >> 6, nn = idx & 63; tile[u * 4160 + kk * 65 + nn] = vals[u][e]; }
        __syncthreads();
#pragma unroll
        for (int u = 0; u < 2; ++u) { const int it = it0 + u * nb;
            if (it < 1088 + 256) { bf16_t* dst; int n0, k0;
                bool cperm = false;
                if (it < 1088) { const int kt = it / 68, nt = it % 68; dst = W1; n0 = nt * 64; k0 = kt * 64; cperm = n0 < 2048; }
                else { const int j = it - 1088, kt = j >> 4, nt = j & 15; dst = W2; n0 = nt * 64; k0 = kt * 64; }
                const int ty = n0 >> 9, cbase = 256 * ((n0 & 511) >> 6) + 128 * (ty & 1) + 4 * (ty >> 1);
#pragma unroll
                for (int e = 0; e < 4; ++e) { const int idx = e * 512 + tid, nn = idx >> 5, kp = idx & 31; const int drow = cperm ? cbase + 32 * (nn >> 4) + 8 * ((nn >> 2) & 3) + (nn & 3) : n0 + nn;
                    *(unsigned*)(dst + (size_t)drow * D + k0 + 2 * kp) = cvt_pk_bf16(tile[u * 4160 + (2 * kp) * 65 + nn], tile[u * 4160 + (2 * kp + 1) * 65 + nn]); } } }
        __syncthreads();
    }
    for (int i = bid * 512 + tid; i < MTOK; i += nb * 512) SS[i] = 0.f;
    const int nw = nb * 8;
    for (int r0 = bid * 8 + wid; r0 < MROWS; r0 += 2 * nw) {
        f32x4 v[2][4];
#pragma unroll
        for (int j = 0; j < 2; ++j) { const int row = r0 + j * nw;
            if (row < MTOK + NDB) { const float* xr = row < MPR ? p.x_prompt + (size_t)row * D : (row < MTOK ? p.x_sample + (size_t)(row - MPR) * D : p.state_shift + (size_t)(row - MTOK) * D);
#pragma unroll
                for (int i = 0; i < 4; ++i) v[j][i] = __builtin_nontemporal_load((const f32x4*)(xr + (lane + 64 * i) * 4)); }
            else {
#pragma unroll
                for (int i = 0; i < 4; ++i) v[j][i] = (f32x4){0.f, 0.f, 0.f, 0.f}; } }
#pragma unroll
        for (int j = 0; j < 2; ++j) { const int row = r0 + j * nw; if (row < MROWS) {
            bf16_t* xo = XN + (size_t)row * D; float rs = 1.0f; float* sh = nullptr;
            if (row < MTOK) { float s = 0.f;
#pragma unroll
                for (int i = 0; i < 4; ++i) s += v[j][i][0] * v[j][i][0] + v[j][i][1] * v[j][i][1] + v[j][i][2] * v[j][i][2] + v[j][i][3] * v[j][i][3];
#pragma unroll
                for (int o = 32; o >= 1; o >>= 1) s += __shfl_xor(s, o);
                rs = rsqrtf(s * (1.0f / 1024.0f) + 1e-6f);
                if (row < MPR) { if ((row & (SEQ - 1)) == SEQ - 1) sh = p.out + OFF_SHIFTP + (size_t)(row >> 11) * D; }
                else { const int rs_ = row - MPR; if ((rs_ & 7) == 7) sh = p.out + OFF_SHIFTS + (size_t)(rs_ >> 3) * D; } }
#pragma unroll
            for (int i = 0; i < 4; ++i) { const int c = (lane + 64 * i) * 4; f32x4 y = v[j][i];
                if (row < MTOK) { const f32x4 g = *(const f32x4*)(p.norm_g + c); y = y * rs * g; }
                u32x2 w; w.x = cvt_pk_bf16(y[0], y[1]); w.y = cvt_pk_bf16(y[2], y[3]); *(u32x2*)(xo + c) = w; if (sh) *(f32x4*)(sh + c) = y; } } }
    }
}

__device__ __forceinline__ void ld8(const bf16_t* ptr, float (&f)[8]) { const u32x4v w = *(const u32x4v*)ptr; f[0] = bflo(w.x); f[1] = bfhi(w.x); f[2] = bflo(w.y); f[3] = bfhi(w.y); f[4] = bflo(w.z); f[5] = bfhi(w.z); f[6] = bflo(w.w); f[7] = bfhi(w.w); }
__device__ void conv_items(const Params& p, int first, int stride, int end, const int tidc, const int tgroups) {
    int tid_ = threadIdx.x; asm volatile("" : "+v"(tid_)); const int tid = tid_;
    const bf16_t* P = (const bf16_t*)(p.ws + WS_P); bf16_t* YC = (bf16_t*)(p.ws + WS_YC);
    const int c0 = (tidc & 63) * 8;
    float cw0[8], cw1[8], cw2[8];
#pragma unroll
    for (int j = 0; j < 8; ++j) { cw0[j] = p.conv_w[c0 + j]; cw1[j] = p.conv_w[512 + c0 + j]; cw2[j] = p.conv_w[1024 + c0 + j]; }
#pragma unroll 1
    for (int it = first; it < end; it += stride) {
        const int R0 = it * (4 * tgroups) + (tidc >> 6) * 4;
        int t0, T; const float* cbuf; float* cout;
        if (R0 < MPR) { const int b = R0 >> 11; t0 = R0 & (SEQ - 1); T = SEQ; cbuf = nullptr; cout = p.out + OFF_CONVP + (size_t)b * 1024; }
        else { const int rs = R0 - MPR, b = rs >> 3; t0 = rs & 7; T = DSEQ; cbuf = p.state_conv + (size_t)b * 1024; cout = p.out + OFF_CONVS + (size_t)b * 1024; }
        const bool inseq = t0 >= 2;
        const bf16_t* pr = P + (size_t)R0 * NP + c0; const bf16_t* pm = inseq ? pr - 2 * NP : pr;
        u32x4v wu[6], wq[4];
#pragma unroll
        for (int k = 0; k < 2; ++k) wu[k] = *(const u32x4v*)(pm + (size_t)k * NP);
#pragma unroll
        for (int k = 0; k < 4; ++k) { wu[2 + k] = *(const u32x4v*)(pr + (size_t)k * NP); wq[k] = *(const u32x4v*)(pr + (size_t)k * NP + 512); }
        float u[6][8];
#pragma unroll
        for (int k = 0; k < 6; ++k) { const unsigned uw[4] = {wu[k].x, wu[k].y, wu[k].z, wu[k].w};
#pragma unroll
            for (int j = 0; j < 4; ++j) { u[k][2 * j] = bflo(uw[j]); u[k][2 * j + 1] = bfhi(uw[j]); } }
        if (!inseq) {
#pragma unroll
            for (int j = 0; j < 8; ++j) { u[0][j] = cbuf ? cbuf[c0 + j] : 0.f; u[1][j] = cbuf ? cbuf[512 + c0 + j] : 0.f; } }
#pragma unroll
        for (int k = 0; k < 4; ++k) { const unsigned qw[4] = {wq[k].x, wq[k].y, wq[k].z, wq[k].w}; float y[8];
#pragma unroll
            for (int j = 0; j < 8; ++j) { const float qg = (j & 1) ? bfhi(qw[j >> 1]) : bflo(qw[j >> 1]);
                y[j] = qg * (cw0[j] * u[k][j] + cw1[j] * u[k + 1][j] + cw2[j] * u[k + 2][j]); }
            u32x4v w; w.x = cvt_pk_bf16(y[0], y[1]); w.y = cvt_pk_bf16(y[2], y[3]); w.z = cvt_pk_bf16(y[4], y[5]); w.w = cvt_pk_bf16(y[6], y[7]);
            *(u32x4v*)(YC + (size_t)(R0 + k) * D + c0) = w; }
        if (t0 + 4 == T) {
#pragma unroll
            for (int j = 0; j < 8; j += 4) { *(f32x4*)(cout + c0 + j) = (f32x4){u[4][j], u[4][j + 1], u[4][j + 2], u[4][j + 3]}; *(f32x4*)(cout + 512 + c0 + j) = (f32x4){u[5][j], u[5][j + 1], u[5][j + 2], u[5][j + 3]}; } }
    }
}

typedef short s16x4 __attribute__((ext_vector_type(4)));
typedef short s16x8 __attribute__((ext_vector_type(8)));
typedef unsigned short __attribute__((may_alias)) us_a; typedef float __attribute__((may_alias)) f32_a; typedef u32x2 __attribute__((may_alias)) u32x2_a;
typedef f32x4 __attribute__((may_alias)) f32x4_a; typedef u32x4v __attribute__((may_alias)) u32x4v_a; typedef s16x8 __attribute__((may_alias)) s16x8_a;
#define DI __device__ __forceinline__
DI u32x2 pk4(const f32x4 v) { u32x2 r; r.x = cvt_pk_bf16(v[0], v[1]); r.y = cvt_pk_bf16(v[2], v[3]); return r; }
DI s16x8 mk8(const u32x2 a, const u32x2 b) { u32x4v t; t.x = a.x; t.y = a.y; t.z = b.x; t.w = b.y; return __builtin_bit_cast(s16x8, t); }
DI s16x4 mk4(const u32x2 a) { return __builtin_bit_cast(s16x4, a); }
DI unsigned short bf1(float x) { return (unsigned short)(cvt_pk_bf16(x, 0.f) & 0xffffu); }
#define MFMA32(a, b, c) __builtin_amdgcn_mfma_f32_16x16x32_bf16((a), (b), (c), 0, 0, 0)
#define MFMA16(a, b, c) __builtin_amdgcn_mfma_f32_16x16x16bf16_1k((a), (b), (c), 0, 0, 0)
template <int CTRL> DI float dppf(float x) { return __int_as_float(__builtin_amdgcn_update_dpp(0, __float_as_int(x), CTRL, 0xf, 0xf, true)); }
template <int CTRL> DI unsigned dppu(unsigned x) { return (unsigned)__builtin_amdgcn_update_dpp(0, (int)x, CTRL, 0xf, 0xf, true); }
constexpr int SB_W = 0, SB_RT = 2304, SB_X0 = 4608, SB_AT = SB_X0 + 2048, SB_BK = 8704, SB_VT = 13312, SB_ARK = 15360, SB_GAM = 16512, SUBSZ = 16768;
constexpr int WROW = 144, BKROW = 72, ARKROW = 72;
struct SubIn { int row0, prevrow, nvalid, h; };

constexpr int LD_WD = 8 * SUBSZ, LD_WA = LD_WD + 8192, LD_PT = LD_WA + 8192, LD_XB = LD_PT + 13 * 256;
static_assert(LD_XB + 16 == LDS_BYTES, "LDS map");
DI void fill_lora(const float* w, int h, int wv, int lane, unsigned char* dst) {
    const int c = lane & 15, q = lane >> 4, mt = wv >> 1, ks = wv & 1; float f[8];
#pragma unroll
    for (int j = 0; j < 8; ++j) f[j] = w[(size_t)(16 * (2 * ks + (j >> 2)) + 4 * q + (j & 3)) * 512 + h * 64 + 16 * mt + c];
    u32x4v o; o.x = cvt_pk_bf16(f[0], f[1]); o.y = cvt_pk_bf16(f[2], f[3]); o.z = cvt_pk_bf16(f[4], f[5]); o.w = cvt_pk_bf16(f[6], f[7]);
    *(u32x4v_a*)(dst + (wv * 64 + lane) * 16) = o;
}
DI void fill_params(const Params& p, int h, unsigned char* lds) {
    for (int i = threadIdx.x; i < 13 * 64; i += 512) { const int row = i >> 6, j = i & 63, hj = h * 64 + j; float v;
        switch (row) { case 0: v = p.mu_shift[hj]; break; case 1: v = p.mu_shift[512 + hj]; break; case 2: v = p.mu_shift[1024 + hj]; break; case 3: v = p.mu_shift[1664 + hj]; break;
            case 4: v = p.mu_shift[1536 + j]; break; case 5: v = p.mu_shift[1600 + j]; break; case 6: v = p.w0[hj]; break; case 7: v = p.a0[hj]; break; case 8: v = p.k_k[hj]; break;
            case 9: v = p.k_a[hj]; break; case 10: v = p.r_k[hj]; break; case 11: v = p.lnx_g[hj]; break; default: v = p.lnx_b[hj]; break; }
        *(f32_a*)(lds + LD_PT + i * 4) = v; }
}
DI f32x4 ptab(const unsigned char* lds, int row, int lane, int n) { return *(const f32x4_a*)(lds + LD_PT + row * 256 + (16 * n + 4 * (lane >> 4)) * 4); }
struct RawQ { u32x2 c[4], pl[4]; };
DI void load_raw(const bf16_t* P, const SubIn& si, int colbase, int lane, RawQ& r) {
    const int t = lane & 15, q = lane >> 4;
    const bf16_t* pc = P + (size_t)(si.row0 + t) * NP + RC + colbase + 4 * q;
    const bf16_t* pp = P + (size_t)(si.prevrow >= 0 ? si.prevrow : MTOK + NDB) * NP + RC + colbase + 4 * q;
#pragma unroll
    for (int n = 0; n < 4; ++n) { r.c[n] = *(const u32x2*)(pc + 16 * n); r.pl[n] = *(const u32x2*)(pp + 16 * n); }
}
DI f32x4 mix_raw(const unsigned char* lds, const RawQ& r, const SubIn& si, int ptrow, int lane, int n) {
    const bool first = (lane & 15) == 0;
    const u32x2 c = r.c[n]; u32x2 pv; pv.x = dppu<0x111>(c.x); pv.y = dppu<0x111>(c.y);
    pv.x = first ? r.pl[n].x : pv.x; pv.y = first ? r.pl[n].y : pv.y;
    const f32x4 mu = ptab(lds, ptrow, lane, n);
    const f32x4 cv = {bflo(c.x), bfhi(c.x), bflo(c.y), bfhi(c.y)}, pvv = {bflo(pv.x), bfhi(pv.x), bflo(pv.y), bfhi(pv.y)};
    return cv + mu * (pvv - cv);
}

DI void load_lead(const Params& p, const SubIn& si, int lane, RawQ& qwl, RawQ& qal) {
    const bf16_t* P = (const bf16_t*)(p.ws + WS_P);
    load_raw(P, si, 1536, lane, qwl); load_raw(P, si, 1600, lane, qal);
}
template <bool ALLV> DI void precompute(const Params& p, unsigned char* lds, unsigned char* rb, const SubIn& si, int lane, float& bonus, const RawQ& qwl, const RawQ& qal) {
    asm volatile("" : "+v"(lane));
    const bf16_t* P = (const bf16_t*)(p.ws + WS_P);
    const int t = lane & 15, q = lane >> 4;
    const float validf = ALLV ? 1.0f : (t < si.nvalid ? 1.0f : 0.0f);
    const f32x4 z4 = {0.f, 0.f, 0.f, 0.f};
    RawQ qk, qr, qv;
    load_raw(P, si, 512 + si.h * 64, lane, qk);
    f32x4 lw[4], av[4];
    { f32x4 wl[4];
#pragma unroll
      for (int n = 0; n < 4; ++n) { wl[n] = mix_raw(lds, qwl, si, 4, lane, n);
#pragma unroll
          for (int e = 0; e < 4; ++e) wl[n][e] = 1.0f - 2.0f * __builtin_amdgcn_rcpf(1.0f + __expf(2.0f * wl[n][e])); }
      const s16x8 tw0 = mk8(pk4(wl[0]), pk4(wl[1])), tw1 = mk8(pk4(wl[2]), pk4(wl[3]));
#pragma unroll
      for (int mt = 0; mt < 4; ++mt) { const s16x8 a0_ = *(const s16x8_a*)(lds + LD_WD + ((mt * 2 + 0) * 64 + lane) * 16), a1_ = *(const s16x8_a*)(lds + LD_WD + ((mt * 2 + 1) * 64 + lane) * 16);
          const f32x4 d = MFMA32(a1_, tw1, MFMA32(a0_, tw0, z4)); const f32x4 w0 = ptab(lds, 6, lane, mt);
#pragma unroll
          for (int e = 0; e < 4; ++e) lw[mt][e] = -0.6065306597126334f * sigmoidf_(d[e] + w0[e]) * validf; } }
    load_raw(P, si, si.h * 64, lane, qr); load_raw(P, si, 1024 + si.h * 64, lane, qv);
    { f32x4 al[4];
#pragma unroll
      for (int n = 0; n < 4; ++n) al[n] = mix_raw(lds, qal, si, 5, lane, n);
      const s16x8 ta0 = mk8(pk4(al[0]), pk4(al[1])), ta1 = mk8(pk4(al[2]), pk4(al[3]));
#pragma unroll
      for (int mt = 0; mt < 4; ++mt) { const s16x8 a0_ = *(const s16x8_a*)(lds + LD_WA + ((mt * 2 + 0) * 64 + lane) * 16), a1_ = *(const s16x8_a*)(lds + LD_WA + ((mt * 2 + 1) * 64 + lane) * 16);
          const f32x4 d = MFMA32(a1_, ta1, MFMA32(a0_, ta0, z4)); const f32x4 a0 = ptab(lds, 7, lane, mt);
#pragma unroll
          for (int e = 0; e < 4; ++e) av[mt][e] = sigmoidf_(d[e] + a0[e]); } }
    f32x4 kr[4];
    float ss = 0.f, bon = 0.f;
#pragma unroll
    for (int n = 0; n < 4; ++n) {
        kr[n] = mix_raw(lds, qk, si, 1, lane, n) * validf; const f32x4 kkw = ptab(lds, 8, lane, n);
#pragma unroll
        for (int e = 0; e < 4; ++e) { const float kk = kr[n][e] * kkw[e]; ss += kk * kk; }
    }
    ss += __shfl_xor(ss, 16); ss += __shfl_xor(ss, 32);
    const float inv = fminf(__builtin_amdgcn_rsqf(ss), 1e12f);
    u32x2 pa[4], pr_[4], pb[4], pk[4];
#pragma unroll
    for (int n = 0; n < 4; ++n) {
        asm volatile("" ::: "memory");
        const f32x4 kkw = ptab(lds, 8, lane, n), kaw = ptab(lds, 9, lane, n), rkw = ptab(lds, 10, lane, n);
        const f32x4 rrn = mix_raw(lds, qr, si, 0, lane, n) * validf, vrn = mix_raw(lds, qv, si, 2, lane, n) * validf;
        f32x4 cum = lw[n];
#pragma unroll
        for (int e = 0; e < 4; ++e) { cum[e] += dppf<0x111>(cum[e]); cum[e] += dppf<0x112>(cum[e]); cum[e] += dppf<0x114>(cum[e]); cum[e] += dppf<0x118>(cum[e]); }
        f32x4 at, rt, bt, kt, bh, kh, gam;
#pragma unroll
        for (int e = 0; e < 4; ++e) {
            const float er = __expf(cum[e]);
            const float ea = __int_as_float(__builtin_amdgcn_update_dpp(0x3f800000, __float_as_int(er), 0x111, 0xf, 0xf, false));
            const float ei = __builtin_amdgcn_rcpf(er), g15 = __shfl(er, (lane & 48) | 15), eh = g15 * ei;
            const float kkn = kr[n][e] * kkw[e] * inv, be = kkn * av[n][e], km = kr[n][e] * (1.0f + (av[n][e] - 1.0f) * kaw[e]);
            bon += rrn[e] * km * rkw[e];
            at[e] = -kkn * ea; rt[e] = rrn[e] * er; bt[e] = be * ei; kt[e] = km * ei; bh[e] = be * eh; kh[e] = km * eh; gam[e] = g15;
        }
        pa[n] = pk4(at); pr_[n] = pk4(rt); pb[n] = pk4(bt); pk[n] = pk4(kt);
        const u32x2 pbh = pk4(bh), pkh = pk4(kh), pv = pk4(vrn);
        *(u32x2_a*)(rb + SB_RT + t * WROW + (16 * n + 4 * q) * 2) = pr_[n];
        if (t == 15) *(f32x4_a*)(rb + SB_GAM + (16 * n + 4 * q) * 4) = gam;
        const int key0 = 16 * n + 4 * q;
        *(us_a*)(rb + SB_X0 + (key0 + 0) * 32 + t * 2) = (unsigned short)(pa[n].x & 0xffffu); *(us_a*)(rb + SB_X0 + (key0 + 1) * 32 + t * 2) = (unsigned short)(pa[n].x >> 16);
        *(us_a*)(rb + SB_X0 + (key0 + 2) * 32 + t * 2) = (unsigned short)(pa[n].y & 0xffffu); *(us_a*)(rb + SB_X0 + (key0 + 3) * 32 + t * 2) = (unsigned short)(pa[n].y >> 16);
        *(us_a*)(rb + SB_VT + (key0 + 0) * 32 + t * 2) = (unsigned short)(pv.x & 0xffffu); *(us_a*)(rb + SB_VT + (key0 + 1) * 32 + t * 2) = (unsigned short)(pv.x >> 16);
        *(us_a*)(rb + SB_VT + (key0 + 2) * 32 + t * 2) = (unsigned short)(pv.y & 0xffffu); *(us_a*)(rb + SB_VT + (key0 + 3) * 32 + t * 2) = (unsigned short)(pv.y >> 16);
        *(us_a*)(rb + SB_BK + (key0 + 0) * BKROW + t * 2) = (unsigned short)(pbh.x & 0xffffu); *(us_a*)(rb + SB_BK + (key0 + 1) * BKROW + t * 2) = (unsigned short)(pbh.x >> 16);
        *(us_a*)(rb + SB_BK + (key0 + 2) * BKROW + t * 2) = (unsigned short)(pbh.y & 0xffffu); *(us_a*)(rb + SB_BK + (key0 + 3) * BKROW + t * 2) = (unsigned short)(pbh.y >> 16);
        *(us_a*)(rb + SB_BK + (key0 + 0) * BKROW + 32 + t * 2) = (unsigned short)(pkh.x & 0xffffu); *(us_a*)(rb + SB_BK + (key0 + 1) * BKROW + 32 + t * 2) = (unsigned short)(pkh.x >> 16);
        *(us_a*)(rb + SB_BK + (key0 + 2) * BKROW + 32 + t * 2) = (unsigned short)(pkh.y & 0xffffu); *(us_a*)(rb + SB_BK + (key0 + 3) * BKROW + 32 + t * 2) = (unsigned short)(pkh.y >> 16);
    }
    bon += __shfl_xor(bon, 16); bon += __shfl_xor(bon, 32); bonus = bon;
    f32x4 Aab, Aak, Arb, Ark;
    { const s16x8 At0 = mk8(pa[0], pa[1]), At1 = mk8(pa[2], pa[3]), Rt0 = mk8(pr_[0], pr_[1]), Rt1 = mk8(pr_[2], pr_[3]);
      const s16x8 Bt0 = mk8(pb[0], pb[1]), Bt1 = mk8(pb[2], pb[3]), Kt0 = mk8(pk[0], pk[1]), Kt1 = mk8(pk[2], pk[3]);
      Aab = MFMA32(At1, Bt1, MFMA32(At0, Bt0, z4)); Aak = MFMA32(At1, Kt1, MFMA32(At0, Kt0, z4));
      Arb = MFMA32(Rt1, Bt1, MFMA32(Rt0, Bt0, z4)); Ark = MFMA32(Rt1, Kt1, MFMA32(Rt0, Kt0, z4)); }
#pragma unroll
    for (int e = 0; e < 4; ++e) { const int trow = 4 * q + e; if (!(t < trow)) { Aab[e] = 0.f; Aak[e] = 0.f; } if (!(t <= trow)) { Arb[e] = 0.f; Ark[e] = 0.f; }
        *(us_a*)(rb + SB_ARK + trow * ARKROW + t * 2) = bf1(Arb[e]); *(us_a*)(rb + SB_ARK + trow * ARKROW + 32 + t * 2) = bf1(Ark[e]); }
    *(f32x4_a*)(rb + SB_AT + t * 64 + 16 * q) = Aab;
    float x[16];
#pragma unroll
    for (int s = 0; s < 16; ++s) x[s] = (s == t) ? 1.0f : 0.0f;
#pragma unroll
    for (int c = 14; c >= 0; --c) {
        if ((c & 1) == 0) asm volatile("" ::: "memory");
        float acc = 0.f;
#pragma unroll
        for (int s4 = (c + 1) / 4; s4 < 4; ++s4) { const f32x4 a = *(const f32x4_a*)(rb + SB_AT + c * 64 + s4 * 16);
#pragma unroll
            for (int e = 0; e < 4; ++e) if (4 * s4 + e > c) acc += x[4 * s4 + e] * a[e]; }
        if (c < t) x[c] = acc;
    }
    f32x4 tq;
#pragma unroll
    for (int e = 0; e < 4; ++e) tq[e] = q == 0 ? x[e] : (q == 1 ? x[4 + e] : (q == 2 ? x[8 + e] : x[12 + e]));
    const s16x4 tB = mk4(pk4(tq));
    f32x4 Wd[4];
#pragma unroll
    for (int m = 0; m < 4; ++m) { const s16x4 aop = mk4(*(const u32x2_a*)(rb + SB_X0 + (16 * m + t) * 32 + 8 * q)); Wd[m] = MFMA16(aop, tB, z4); }
    const f32x4 Qt = MFMA16(mk4(pk4(Aak)), tB, z4);
    const s16x4 qB = mk4(pk4(Qt));
    f32x4 X0d[4];
#pragma unroll
    for (int m = 0; m < 4; ++m) { const s16x4 aop = mk4(*(const u32x2_a*)(rb + SB_VT + (16 * m + t) * 32 + 8 * q)); X0d[m] = MFMA16(aop, qB, z4); }
#pragma unroll
    for (int m = 0; m < 4; ++m) { *(u32x2_a*)(rb + SB_W + t * WROW + (16 * m + 4 * q) * 2) = pk4(Wd[m]);
#pragma unroll
        for (int e = 0; e < 4; ++e) *(f32_a*)(rb + SB_X0 + (16 * m + 4 * q + e) * 64 + t * 4) = X0d[m][e]; }
}

DI void epilogue_core(const Params& p, unsigned char* lds, const SubIn& si, int lane, f32x4 (&o)[4], float bonus, const RawQ& qg, const RawQ& qv) {
    const int t = lane & 15, q = lane >> 4, hb = si.h * 64 + 4 * q;
    float sm = 0.f;
#pragma unroll
    for (int n = 0; n < 4; ++n) sm += (o[n][0] + o[n][1]) + (o[n][2] + o[n][3]);
    sm += __shfl_xor(sm, 16); sm += __shfl_xor(sm, 32);
    const float mean = sm * (1.0f / 64.0f); float vs = 0.f;
#pragma unroll
    for (int n = 0; n < 4; ++n)
#pragma unroll
        for (int e = 0; e < 4; ++e) { o[n][e] -= mean; vs += o[n][e] * o[n][e]; }
    vs += __shfl_xor(vs, 16); vs += __shfl_xor(vs, 32);
    const float rstd = rsqrtf(vs * (1.0f / 64.0f) + 64e-5f);
    bf16_t* yc = (bf16_t*)(p.ws + WS_YC) + (size_t)(si.row0 + t) * D + 512 + hb;
#pragma unroll
    for (int n = 0; n < 4; ++n) { const f32x4 lg = ptab(lds, 11, lane, n), lb = ptab(lds, 12, lane, n), gv = mix_raw(lds, qg, si, 3, lane, n), vv = mix_raw(lds, qv, si, 2, lane, n); f32x4 y;
#pragma unroll
        for (int e = 0; e < 4; ++e) y[e] = (o[n][e] * rstd * lg[e] + lb[e] + bonus * vv[e]) * siluf_(gv[e]);
        if (t < si.nvalid) *(u32x2*)(yc + 16 * n) = pk4(y); }
}
DI void scan_epilogue(const Params& p, unsigned char* lds, unsigned char* rb, const SubIn& si, int lane, float bonus, const RawQ& qg, const RawQ& qv) {
    asm volatile("" : "+v"(lane));
    const int t = lane & 15, q = lane >> 4;
    f32x4 o[4];
#pragma unroll
    for (int n = 0; n < 4; ++n)
#pragma unroll
        for (int e = 0; e < 4; ++e) o[n][e] = *(const f32_a*)(rb + SB_X0 + (16 * n + 4 * q + e) * 64 + t * 4);
    epilogue_core(p, lds, si, lane, o, bonus, qg, qv);
}

template <int IDENT> DI void chain_step_seg2(const unsigned char* rb, int v0, int c, int q, f32x4 (&st)[2][4], float* oz, bf16_t* rho) {
    const unsigned char* wr_ = rb + SB_W + c * WROW + 8 * q; const unsigned char* rr_ = rb + SB_RT + c * WROW + 8 * q; const unsigned char* ar = rb + SB_ARK + c * ARKROW + 8 * q;
    const s16x8 wa1 = mk8(*(const u32x2_a*)(wr_), *(const u32x2_a*)(wr_ + 32)), wa2 = mk8(*(const u32x2_a*)(wr_ + 64), *(const u32x2_a*)(wr_ + 96));
    const s16x8 ra1 = mk8(*(const u32x2_a*)(rr_), *(const u32x2_a*)(rr_ + 32)), ra2 = mk8(*(const u32x2_a*)(rr_ + 64), *(const u32x2_a*)(rr_ + 96));
    const s16x8 ark = mk8(*(const u32x2_a*)(ar), *(const u32x2_a*)(ar + 32));
    s16x8 bk[4]; f32x4 g[4];
#pragma unroll
    for (int m = 0; m < 4; ++m) { const unsigned char* bp = rb + SB_BK + (16 * m + c) * BKROW + 8 * q; bk[m] = mk8(*(const u32x2_a*)(bp), *(const u32x2_a*)(bp + 32)); g[m] = *(const f32x4_a*)(rb + SB_GAM + (16 * m + 4 * q) * 4); }
#pragma unroll
    for (int nt = 0; nt < 2; ++nt) {
        const int i = 16 * (v0 + nt) + c;
        const s16x8 b1 = mk8(pk4(st[nt][0]), pk4(st[nt][1])), b2 = mk8(pk4(st[nt][2]), pk4(st[nt][3]));
        f32x4 U = {0.f, 0.f, 0.f, 0.f};
        if (!IDENT) U = *(const f32x4_a*)(rb + SB_X0 + i * 64 + 16 * q);
        U = MFMA32(wa2, b2, MFMA32(wa1, b1, U));
        f32x4 O = {0.f, 0.f, 0.f, 0.f};
        O = MFMA32(ra2, b2, MFMA32(ra1, b1, O));
        u32x2 vt; vt.x = 0u; vt.y = 0u;
        if (!IDENT) vt = *(const u32x2_a*)(rb + SB_VT + i * 32 + 8 * q);
        const s16x8 uv = mk8(pk4(U), vt);
        O = MFMA32(ark, uv, O);
#pragma unroll
        for (int m = 0; m < 4; ++m) st[nt][m] = MFMA32(bk[m], uv, st[nt][m] * g[m]);
        if (!IDENT) {
#pragma unroll
            for (int e = 0; e < 4; ++e) oz[(size_t)(4 * q + e) * 512 + i] = O[e]; }
        else {
#pragma unroll
            for (int e = 0; e < 4; ++e) rho[(size_t)(4 * q + e) * 512 + i] = bf1(O[e]); }
    }
}

__device__ void scan_segments(const Params& p, unsigned char* lds, int item) {
    int tid_ = threadIdx.x; asm volatile("" : "+v"(tid_)); const int tid = tid_, w = tid >> 6, lane = tid & 63, q = lane >> 4, c = lane & 15;
    const int it = item >> 2, j = item & 3, b = it >> 3, h = it & 7, v = w & 3;
    float* OZ = (float*)(p.ws + WS_OZ); bf16_t* RHO = (bf16_t*)(p.ws + WS_RHO); float* BON = (float*)(p.ws + WS_BON); float* MN = (float*)(p.ws + WS_MN);
    unsigned char* rb = lds + w * SUBSZ;
    __syncthreads();
    fill_lora(p.w_dec2, h, w, lane, lds + LD_WD); fill_lora(p.w_a2, h, w, lane, lds + LD_WA); fill_params(p, h, lds);
    __syncthreads();
    const int v0 = (w & 1) * 2; const bool ident = (w & 2) != 0;
    f32x4 st[2][4];
#pragma unroll
    for (int nt = 0; nt < 2; ++nt)
#pragma unroll
        for (int m = 0; m < 4; ++m)
#pragma unroll
            for (int e = 0; e < 4; ++e) st[nt][m][e] = (ident && (16 * m + 4 * q + e) == (16 * (v0 + nt) + c)) ? 1.0f : 0.0f;
    const int seg0 = b * SEQ + j * 512;
#pragma unroll 1
    for (int mc = 0; mc < 4; ++mc) {
        SubIn si; si.h = h; si.row0 = seg0 + mc * 128 + w * 16; si.prevrow = (j == 0 && mc == 0 && w == 0) ? -1 : si.row0 - 1; si.nvalid = 16;
        float bonus;
#ifndef REPPRE
#define REPPRE 1
#endif
#ifndef REPCH
#define REPCH 1
#endif
#pragma unroll 1
        for (int rp = 0; rp < REPPRE; ++rp) { RawQ qwl, qal; load_lead(p, si, lane, qwl, qal); precompute<true>(p, lds, rb, si, lane, bonus, qwl, qal); }
        if (lane < 16) BON[(size_t)(si.row0 + lane) * 8 + h] = bonus;
        unsigned d0 = 0u, d1 = 0u;
        if (mc < 3) {
            const bf16_t* nx = (const bf16_t*)(p.ws + WS_P) + (size_t)(si.row0 + 128 + c) * NP + RC; const int sg = q == 0 ? h * 64 : (q == 1 ? 512 + h * 64 : (q == 2 ? 1024 + h * 64 : 1664 + h * 64));
            d0 = *(const unsigned*)(nx + sg); d1 = *(const unsigned*)(nx + 1536 + (q & 1) * 64); }
        __syncthreads();
        if (w < 4) { int ln = lane; asm volatile("" : "+v"(ln)); const int cc = ln & 15, qq = ln >> 4;
            __builtin_amdgcn_s_setprio(3);
#if REPCH > 1
            f32x4 sv[2][4];
            for (int a_ = 0; a_ < 2; ++a_) for (int b_ = 0; b_ < 4; ++b_) sv[a_][b_] = st[a_][b_];
#pragma unroll 1
            for (int rc = 0; rc < REPCH; ++rc) {
            for (int a_ = 0; a_ < 2; ++a_) for (int b_ = 0; b_ < 4; ++b_) st[a_][b_] = sv[a_][b_];
#endif
#pragma unroll 1
            for (int d = 0; d < 8; ++d) { const size_t ro = (size_t)(seg0 + mc * 128 + d * 16) * 512 + h * 64;
                if (!ident) chain_step_seg2<0>(lds + d * SUBSZ, v0, cc, qq, st, OZ + ro, nullptr); else chain_step_seg2<1>(lds + d * SUBSZ, v0, cc, qq, st, nullptr, RHO + ro); }
#if REPCH > 1
            }
#endif
            __builtin_amdgcn_s_setprio(0);
        } else if (gridDim.x == 256) {
            conv_items(p, (int)blockIdx.x + 256 * mc, 1024, mc == 0 ? MTOK / 16 : 0x7fffffff & ((int)blockIdx.x + 256 * mc + 1), tid - 256, 4);
        }
        asm volatile("" :: "v"(d0), "v"(d1));
        __syncthreads();
    }
    if (w < 4) {
#pragma unroll
        for (int nt = 0; nt < 2; ++nt) { float* so = MN + ((size_t)item * 2 + (ident ? 1 : 0)) * 4096 + (16 * (v0 + nt) + c) * 64 + 4 * q;
#pragma unroll
            for (int m = 0; m < 4; ++m) { const f32x4 sv = st[nt][m];
                __hip_atomic_store((unsigned long long*)(so + 16 * m), (unsigned long long)__float_as_uint(sv[0]) | ((unsigned long long)__float_as_uint(sv[1]) << 32), __ATOMIC_RELAXED, __HIP_MEMORY_SCOPE_AGENT);
                __hip_atomic_store((unsigned long long*)(so + 16 * m + 2), (unsigned long long)__float_as_uint(sv[2]) | ((unsigned long long)__float_as_uint(sv[3]) << 32), __ATOMIC_RELAXED, __HIP_MEMORY_SCOPE_AGENT); } }
        asm volatile("s_waitcnt vmcnt(0)" ::: "memory");
        if (lane == 0) (void)__hip_atomic_fetch_add((unsigned*)(p.ws + WS_CHC) + 64 * it, 1u, __ATOMIC_RELAXED, __HIP_MEMORY_SCOPE_AGENT); }
}

struct FxIn { RawQ qg, qv; f32x4 o[4]; s16x8 r0, r1; float bonus; };
DI void fx_load(const Params& p, FxIn& in, int seg0, int mc, int j, int h, int w, int ln) {
    SubIn si; si.h = h; si.row0 = seg0 + mc * 128 + w * 16; si.prevrow = (j == 0 && mc == 0 && w == 0) ? -1 : si.row0 - 1; si.nvalid = 16;
    const bf16_t* P = (const bf16_t*)(p.ws + WS_P); const int t = ln & 15, qq = ln >> 4;
    load_raw(P, si, 1664 + h * 64, ln, in.qg); load_raw(P, si, 1024 + h * 64, ln, in.qv);
    const size_t ro = (size_t)(si.row0 + t) * 512 + h * 64;
    const float* OZ = (const float*)(p.ws + WS_OZ); const bf16_t* RHO = (const bf16_t*)(p.ws + WS_RHO);
#pragma unroll
    for (int m = 0; m < 4; ++m) in.o[m] = *(const f32x4*)(OZ + ro + 16 * m + 4 * qq);
    in.r0 = *(const s16x8*)(RHO + ro + 8 * qq); in.r1 = *(const s16x8*)(RHO + ro + 32 + 8 * qq);
    in.bonus = ((const float*)(p.ws + WS_BON))[(size_t)(si.row0 + t) * 8 + h];
}
constexpr int LD_SBF = 69632, LD_MT = 79872;
DI void sub_barrier4(unsigned char* lds, unsigned& gen) {
    asm volatile("s_waitcnt vmcnt(0) lgkmcnt(0)" ::: "memory");
    ++gen;
    if ((threadIdx.x & 63) == 0) (void)__hip_atomic_fetch_add((unsigned*)(lds + LD_XB + 8), 1u, __ATOMIC_RELAXED, __HIP_MEMORY_SCOPE_WORKGROUP);
    while (__hip_atomic_load((unsigned*)(lds + LD_XB + 8), __ATOMIC_RELAXED, __HIP_MEMORY_SCOPE_WORKGROUP) < 4u * gen) __builtin_amdgcn_s_sleep(1);
    asm volatile("" ::: "memory");
}
__device__ void fix_sstart4(const Params& p, unsigned char* lds, int item, int wq, int lane) {
    const int it = item >> 2, j = item & 3; if (j == 0) return;
    const int q = lane >> 4, c = lane & 15, t256 = wq * 64 + lane, ri = t256 >> 3, kg = (t256 & 7) * 8;
    const float* MN = (const float*)(p.ws + WS_MN) + (size_t)it * 4 * 2 * 4096;
    unsigned char* SBF = lds + LD_SBF; unsigned char* MT = lds + LD_MT;
    { const unsigned* chc = (const unsigned*)(p.ws + WS_CHC) + 64 * it; unsigned sp = 0u;
      while ((unsigned)__builtin_amdgcn_readfirstlane(__hip_atomic_load(chc, __ATOMIC_RELAXED, __HIP_MEMORY_SCOPE_AGENT)) < 16u) { __builtin_amdgcn_s_sleep(2); if (++sp > (1u << 22)) break; }
      asm volatile("s_waitcnt vmcnt(0)" ::: "memory"); }
    const int nst = j == 3 ? 3 : j - 1;
    unsigned gen = 0u;
#pragma unroll
    for (int rr = 0; rr < 64; rr += 32) { const f32x4 a0 = *(const f32x4*)(MN + (ri + rr) * 64 + kg), a1 = *(const f32x4*)(MN + (ri + rr) * 64 + kg + 4);
        u32x4v o; o.x = cvt_pk_bf16(a0[0], a0[1]); o.y = cvt_pk_bf16(a0[2], a0[3]); o.z = cvt_pk_bf16(a1[0], a1[1]); o.w = cvt_pk_bf16(a1[2], a1[3]);
        *(u32x4v_a*)(SBF + (ri + rr) * 144 + kg * 2) = o; }
#pragma unroll 1
    for (int jj = 1; jj <= nst; ++jj) {
        const float* Nj = MN + (size_t)jj * 2 * 4096; const float* Mj = Nj + 4096;
#pragma unroll
        for (int rr = 0; rr < 64; rr += 32) { const f32x4 m0 = *(const f32x4*)(Mj + (ri + rr) * 64 + kg), m1 = *(const f32x4*)(Mj + (ri + rr) * 64 + kg + 4);
#pragma unroll
            for (int e = 0; e < 4; ++e) { *(us_a*)(MT + (kg + e) * 144 + (ri + rr) * 2) = bf1(m0[e]); *(us_a*)(MT + (kg + 4 + e) * 144 + (ri + rr) * 2) = bf1(m1[e]); } }
        f32x4 ci[4];
#pragma unroll
        for (int ct = 0; ct < 4; ++ct)
#pragma unroll
            for (int e = 0; e < 4; ++e) ci[ct][e] = Nj[(16 * wq + 4 * q + e) * 64 + 16 * ct + c];
        sub_barrier4(lds, gen);
        const s16x8 sa0 = *(const s16x8_a*)(SBF + (16 * wq + c) * 144 + (8 * q) * 2), sa1 = *(const s16x8_a*)(SBF + (16 * wq + c) * 144 + (32 + 8 * q) * 2);
        f32x4 dn[4];
#pragma unroll
        for (int ct = 0; ct < 4; ++ct) { const s16x8 b0 = *(const s16x8_a*)(MT + (16 * ct + c) * 144 + (8 * q) * 2), b1 = *(const s16x8_a*)(MT + (16 * ct + c) * 144 + (32 + 8 * q) * 2);
            dn[ct] = MFMA32(sa1, b1, MFMA32(sa0, b0, ci[ct])); }
        sub_barrier4(lds, gen);
#pragma unroll
        for (int ct = 0; ct < 4; ++ct)
#pragma unroll
            for (int e = 0; e < 4; ++e) { const int i = 16 * wq + 4 * q + e, key = 16 * ct + c;
                if (jj == 3) p.out[OFF_WKVP + (size_t)it * 4096 + i * 64 + key] = dn[ct][e];
                else *(us_a*)(SBF + i * 144 + key * 2) = bf1(dn[ct][e]); }
    }
}
__device__ void scan_fixup(const Params& p, unsigned char* lds, int item, const int skip_tiles, const bool sdone) {
    int tid_ = threadIdx.x; asm volatile("" : "+v"(tid_)); const int tid = tid_, w = tid >> 6, lane = tid & 63, q = lane >> 4, c = lane & 15;
    const int it = item >> 2, j = item & 3, b = it >> 3, h = it & 7;
    const float* OZ = (const float*)(p.ws + WS_OZ); const bf16_t* RHO = (const bf16_t*)(p.ws + WS_RHO); const float* BON = (const float*)(p.ws + WS_BON);
    const float* MN = (const float*)(p.ws + WS_MN) + (size_t)it * 4 * 2 * 4096; const bf16_t* P = (const bf16_t*)(p.ws + WS_P);
    float* SA = (float*)lds; float* SBb = SA + 4096; unsigned char* SBF = lds + LD_SBF;
    __syncthreads();
    if (!sdone) fill_params(p, h, lds);
    const int seg0 = b * SEQ + j * 512;
    int ln = lane; asm volatile("" : "+v"(ln));
    FxIn fin[2]; fx_load(p, fin[0], seg0, 0, j, h, w, ln);
    if (!sdone) {
    if (tid < 64) { const unsigned* chc = (const unsigned*)(p.ws + WS_CHC) + 64 * it; unsigned sp = 0u;
        while ((unsigned)__builtin_amdgcn_readfirstlane(__hip_atomic_load(chc, __ATOMIC_RELAXED, __HIP_MEMORY_SCOPE_AGENT)) < 16u) { __builtin_amdgcn_s_sleep(2); if (++sp > (1u << 22)) break; }
        asm volatile("s_waitcnt vmcnt(0)" ::: "memory"); }
    __syncthreads();
    const int ri = tid >> 3, kg = (tid & 7) * 8;
    const int nst = j == 0 ? 0 : (j == 3 ? 3 : j - 1);
    unsigned char* MT = lds + LD_MT;
    const int rt = w >> 1, ct0 = 2 * (w & 1);
    f32x4 mA[4], mB[4]; float nd[4][2][4];
#pragma unroll
    for (int jj = 1; jj < 4; ++jj) { mA[jj] = mB[jj] = (f32x4){0.f, 0.f, 0.f, 0.f};
#pragma unroll
        for (int tt = 0; tt < 2; ++tt)
#pragma unroll
            for (int e = 0; e < 4; ++e) nd[jj][tt][e] = 0.f;
        if (jj <= nst) { const float* Nj = MN + (size_t)jj * 2 * 4096; mA[jj] = *(const f32x4*)(Nj + 4096 + ri * 64 + kg); mB[jj] = *(const f32x4*)(Nj + 4096 + ri * 64 + kg + 4);
#pragma unroll
            for (int tt = 0; tt < 2; ++tt)
#pragma unroll
                for (int e = 0; e < 4; ++e) nd[jj][tt][e] = Nj[(16 * rt + 4 * q + e) * 64 + 16 * (ct0 + tt) + c]; } }
    { f32x4 a0 = {0.f, 0.f, 0.f, 0.f}, a1 = a0; if (j > 0) { a0 = *(const f32x4*)(MN + ri * 64 + kg); a1 = *(const f32x4*)(MN + ri * 64 + kg + 4); }
      u32x4v o; o.x = cvt_pk_bf16(a0[0], a0[1]); o.y = cvt_pk_bf16(a0[2], a0[3]); o.z = cvt_pk_bf16(a1[0], a1[1]); o.w = cvt_pk_bf16(a1[2], a1[3]);
      *(u32x4v_a*)(SBF + ri * 144 + kg * 2) = o; }
#pragma unroll
    for (int jj = 1; jj <= 3; ++jj) if (jj <= nst) {
#pragma unroll
        for (int e = 0; e < 4; ++e) { *(us_a*)(MT + (kg + e) * 144 + ri * 2) = bf1(mA[jj][e]); *(us_a*)(MT + (kg + 4 + e) * 144 + ri * 2) = bf1(mB[jj][e]); }
        __syncthreads();
        const s16x8 sa0 = *(const s16x8_a*)(SBF + (16 * rt + c) * 144 + (8 * q) * 2), sa1 = *(const s16x8_a*)(SBF + (16 * rt + c) * 144 + (32 + 8 * q) * 2);
        f32x4 dn[2];
#pragma unroll
        for (int tt = 0; tt < 2; ++tt) { const s16x8 b0 = *(const s16x8_a*)(MT + (16 * (ct0 + tt) + c) * 144 + (8 * q) * 2), b1 = *(const s16x8_a*)(MT + (16 * (ct0 + tt) + c) * 144 + (32 + 8 * q) * 2);
            const f32x4 ci = {nd[jj][tt][0], nd[jj][tt][1], nd[jj][tt][2], nd[jj][tt][3]}; dn[tt] = MFMA32(sa1, b1, MFMA32(sa0, b0, ci)); }
        __syncthreads();
#pragma unroll
        for (int tt = 0; tt < 2; ++tt)
#pragma unroll
            for (int e = 0; e < 4; ++e) { const int i = 16 * rt + 4 * q + e, key = 16 * (ct0 + tt) + c;
                if (jj == 3) p.out[OFF_WKVP + (size_t)it * 4096 + i * 64 + key] = dn[tt][e];
                else *(us_a*)(SBF + i * 144 + key * 2) = bf1(dn[tt][e]); }
    }
    }
    __syncthreads();
    if (!skip_tiles)
#pragma unroll
    for (int mc = 0; mc < 4; ++mc) {
        if (mc < 3) fx_load(p, fin[(mc + 1) & 1], seg0, mc + 1, j, h, w, ln);
        FxIn& in = fin[mc & 1];
        SubIn si; si.h = h; si.row0 = seg0 + mc * 128 + w * 16; si.prevrow = (j == 0 && mc == 0 && w == 0) ? -1 : si.row0 - 1; si.nvalid = 16;
        const int t = ln & 15, qq = ln >> 4;
        if (j > 0) {
#pragma unroll
            for (int m = 0; m < 4; ++m) { const s16x8 a0_ = *(const s16x8_a*)(SBF + (16 * m + t) * 144 + (8 * qq) * 2), a1_ = *(const s16x8_a*)(SBF + (16 * m + t) * 144 + (32 + 8 * qq) * 2);
                in.o[m] = MFMA32(a1_, in.r1, MFMA32(a0_, in.r0, in.o[m])); } }
        epilogue_core(p, lds, si, ln, in.o, in.bonus, in.qg, in.qv);
    }
    __syncthreads();
}

DI void sample_chain(unsigned char* rb, int lane, const float* s_in, float* s_out) {
    asm volatile("" : "+v"(lane));
    const int c = lane & 15, q = lane >> 4;
    f32x4 st[4][4];
#pragma unroll
    for (int v = 0; v < 4; ++v)
#pragma unroll
        for (int m = 0; m < 4; ++m) st[v][m] = *(const f32x4*)(s_in + (16 * v + c) * 64 + 16 * m + 4 * q);
    const unsigned char* wr_ = rb + SB_W + c * WROW + 8 * q; const unsigned char* rr_ = rb + SB_RT + c * WROW + 8 * q; const unsigned char* ar = rb + SB_ARK + c * ARKROW + 8 * q;
    const s16x8 wa1 = mk8(*(const u32x2_a*)(wr_), *(const u32x2_a*)(wr_ + 32)), wa2 = mk8(*(const u32x2_a*)(wr_ + 64), *(const u32x2_a*)(wr_ + 96));
    const s16x8 ra1 = mk8(*(const u32x2_a*)(rr_), *(const u32x2_a*)(rr_ + 32)), ra2 = mk8(*(const u32x2_a*)(rr_ + 64), *(const u32x2_a*)(rr_ + 96));
    const s16x8 ark = mk8(*(const u32x2_a*)(ar), *(const u32x2_a*)(ar + 32));
    s16x8 bk[4]; f32x4 g[4];
#pragma unroll
    for (int m = 0; m < 4; ++m) { const unsigned char* bp = rb + SB_BK + (16 * m + c) * BKROW + 8 * q; bk[m] = mk8(*(const u32x2_a*)(bp), *(const u32x2_a*)(bp + 32)); g[m] = *(const f32x4_a*)(rb + SB_GAM + (16 * m + 4 * q) * 4); }
#pragma unroll
    for (int v = 0; v < 4; ++v) {
        const int i = 16 * v + c;
        const s16x8 b1 = mk8(pk4(st[v][0]), pk4(st[v][1])), b2 = mk8(pk4(st[v][2]), pk4(st[v][3]));
        f32x4 U = *(const f32x4_a*)(rb + SB_X0 + i * 64 + 16 * q);
        U = MFMA32(wa2, b2, MFMA32(wa1, b1, U));
        f32x4 O = {0.f, 0.f, 0.f, 0.f};
        O = MFMA32(ra2, b2, MFMA32(ra1, b1, O));
        const s16x8 uv = mk8(pk4(U), *(const u32x2_a*)(rb + SB_VT + i * 32 + 8 * q));
        O = MFMA32(ark, uv, O);
#pragma unroll
        for (int m = 0; m < 4; ++m) { const f32x4 sn = MFMA32(bk[m], uv, st[v][m] * g[m]); *(f32x4*)(s_out + (16 * v + c) * 64 + 16 * m + 4 * q) = sn; }
        *(f32x4_a*)(rb + SB_X0 + i * 64 + 16 * q) = O;
    }
}
__device__ void scan_tail(const Params& p, unsigned char* lds) {
    int tid_ = threadIdx.x; asm volatile("" : "+v"(tid_)); const int tid = tid_, w = tid >> 6, lane = tid & 63;
    const int nb = gridDim.x, bid = blockIdx.x; const bool conc = nb == 256;
    unsigned char* rb = lds + w * SUBSZ;
#pragma unroll 1
    for (int ms = conc ? 0 : bid; ms < (conc ? 1 : NDB); ms += (conc ? 1 : nb)) {
        int h, b;
        if (conc) { const int it = bid >> 2, k = (it >> 3) * 4 + (bid & 3); h = it & 7; b = (k >> 1) * 8 + (k & 1) * 4 + w; }
        else { h = ms & 7; b = (ms >> 3) * 8 + w; __syncthreads();
               fill_lora(p.w_dec2, h, w, lane, lds + LD_WD); fill_lora(p.w_a2, h, w, lane, lds + LD_WA); fill_params(p, h, lds); __syncthreads(); }
        if (w < (conc ? 4 : 8)) {
            SubIn si; si.h = h; si.row0 = MPR + b * DSEQ; si.prevrow = MTOK + b; si.nvalid = DSEQ;
            float bonus;
            const size_t so = (size_t)(b * 8 + h) * 4096;
            const float th0 = p.state_wkv[so + lane * 32], th1 = p.state_wkv[so + 2048 + lane * 32];
            { RawQ qwl, qal; load_lead(p, si, lane, qwl, qal); precompute<false>(p, lds, rb, si, lane, bonus, qwl, qal); }
            asm volatile("" :: "v"(th0), "v"(th1));
            sample_chain(rb, lane, p.state_wkv + so, p.out + OFF_WKVS + so);
            { RawQ qg, qv2; load_raw((const bf16_t*)(p.ws + WS_P), si, 1664 + si.h * 64, lane, qg); load_raw((const bf16_t*)(p.ws + WS_P), si, 1024 + si.h * 64, lane, qv2);
              scan_epilogue(p, lds, rb, si, lane, bonus, qg, qv2); }
        }
    }
    if (!conc) __syncthreads();
    if (!conc) conv_items(p, bid, nb, MTOK / 32, tid, 8);
    else if (w >= 4) fix_sstart4(p, lds, bid, w - 4, lane);
}
__device__ void phase2(const Params& p, unsigned char* lds) {
    const int nb = gridDim.x, bid = blockIdx.x;
#pragma unroll 1
    for (int item = bid; item < 256; item += nb) scan_segments(p, lds, item);
    scan_tail(p, lds);
}
__device__ void phase2b(const Params& p, unsigned char* lds, const int skip_tiles) {
    const int nb = gridDim.x, bid = blockIdx.x;
#pragma unroll 1
    for (int item = bid; item < 256; item += nb) scan_fixup(p, lds, item, skip_tiles, nb == 256);
}

struct EpiResid {
    static constexpr bool PERM = false, AFTER_DRAIN = false;
    const float* xp; const float* xs; float* out; float* ss;
    __device__ __forceinline__ void operator()(const f32x4 (&acc)[2][2][4][2], const pg8::Unit& u, int wr, int wc, int fr, int fq) const {
        const int row0 = u.pm * 256 + wr * 64 + fr, col0 = u.pn * 256 + wc * 32 + 4 * fq;
#pragma unroll
        for (int ai = 0; ai < 2; ++ai)
#pragma unroll
            for (int m = 0; m < 4; ++m) {
                const int row = row0 + ai * 128 + m * 16;
                const float* xr = (row < MPR ? xp + (size_t)row * D : xs + (size_t)(row - MPR) * D) + col0; float* orow = out + (size_t)row * D + col0; float s = 0.f;
#pragma unroll
                for (int bj = 0; bj < 2; ++bj)
#pragma unroll
                    for (int n = 0; n < 2; ++n) { const f32x4 hv = *(const f32x4*)(xr + bj * 128 + n * 16) + acc[ai][bj][m][n]; *(f32x4*)(orow + bj * 128 + n * 16) = hv; s += hv[0] * hv[0] + hv[1] * hv[1] + hv[2] * hv[2] + hv[3] * hv[3]; }
                s += __shfl_xor(s, 16); s += __shfl_xor(s, 32);
                if (fq == 0) atomicAdd(ss + row, s);
            }
    }
};

__device__ __forceinline__ void group_barrier(unsigned* cnt, unsigned target) {
    asm volatile("s_waitcnt vmcnt(0)" ::: "memory");
    __syncthreads();
    if (threadIdx.x == 0) {
        __builtin_amdgcn_fence(__ATOMIC_RELEASE, "agent"); asm volatile("s_waitcnt vmcnt(0)" ::: "memory");
        (void)xb_add(cnt, 1u);
        unsigned sp = 0u; while (xb_ld(cnt) < target) { __builtin_amdgcn_s_sleep(1); if (++sp > (1u << 22)) break; }
        __builtin_amdgcn_fence(__ATOMIC_ACQUIRE, "agent"); asm volatile("s_waitcnt vmcnt(0)" ::: "memory");
    }
    __syncthreads();
}
__device__ void phase4(const Params& p, const int row_begin, const int row_end, const int first_wave, const int nw) {
    int tid_ = threadIdx.x; asm volatile("" : "+v"(tid_)); const int lane = tid_ & 63;
    const bf16_t* Y = (const bf16_t*)(p.ws + WS_XN);
    f32x4 g[4];
#pragma unroll
    for (int i = 0; i < 4; ++i) g[i] = *(const f32x4*)(p.final_g + (lane + 64 * i) * 4);
    if (first_wave < 0) return;
    for (int r0 = row_begin + first_wave; r0 < row_end; r0 += 4 * nw) {
        f32x4 hv[4][4]; float s[4] = {0.f, 0.f, 0.f, 0.f};
#pragma unroll
        for (int j = 0; j < 4; ++j) { const int row = r0 + j * nw; if (row < row_end) {
            const float* xr = row < MPR ? p.x_prompt + (size_t)row * D : p.x_sample + (size_t)(row - MPR) * D; const bf16_t* yr = Y + (size_t)row * D;
#pragma unroll
            for (int i = 0; i < 4; ++i) { const int c = (lane + 64 * i) * 4; const f32x4 x = __builtin_nontemporal_load((const f32x4*)(xr + c)); const u32x2 y = __builtin_nontemporal_load((const u32x2*)(yr + c));
                hv[j][i] = x + (f32x4){bflo(y.x), bfhi(y.x), bflo(y.y), bfhi(y.y)}; } } }
#pragma unroll
        for (int j = 0; j < 4; ++j) { const int row = r0 + j * nw; if (row < row_end) {
#pragma unroll
            for (int i = 0; i < 4; ++i) s[j] += hv[j][i][0] * hv[j][i][0] + hv[j][i][1] * hv[j][i][1] + hv[j][i][2] * hv[j][i][2] + hv[j][i][3] * hv[j][i][3];
#pragma unroll
            for (int o = 32; o >= 1; o >>= 1) s[j] += __shfl_xor(s[j], o);
            const float rs = rsqrtf(s[j] * (1.0f / 1024.0f) + 1e-6f); float* orow = p.out + (size_t)row * D;
#pragma unroll
            for (int i = 0; i < 4; ++i) __builtin_nontemporal_store(hv[j][i] * rs * g[i], (f32x4*)(orow + (lane + 64 * i) * 4)); } }
    }
}

__global__ void __launch_bounds__(512, 2) fwd_megakernel(Params p) {
    extern __shared__ __attribute__((aligned(16))) unsigned char lds[];
    cg::grid_group grid = cg::this_grid();
    if (threadIdx.x == 0) { *(volatile unsigned*)(lds + LD_XB) = 0u; *(volatile unsigned*)(lds + LD_XB + 4) = 0u; *(volatile unsigned*)(lds + LD_XB + 8) = 0u; }
    __syncthreads();
    const XcdBarrier xb = xcd_barrier_post((unsigned*)(p.ws + WS_BAR), (volatile LAS unsigned*)(lds + LD_XB));
#ifndef REP0
#define REP0 1
#endif
#ifndef REP1
#define REP1 1
#endif
#ifndef REP2
#define REP2 1
#endif
#ifndef REPS
#define REPS 0
#endif
#ifndef REPALL
#define REPALL 1
#endif
#ifndef SKIPM
#define SKIPM 0
#endif
#define RUNPH(bit) (fwd == 0 || !((SKIPM >> (bit)) & 1))
#pragma unroll 1
    for (int fwd = 0; fwd < REPALL; ++fwd) {
    if (fwd) xcd_barrier(xb);
    for (int rep = 0; rep < REP0; ++rep) phase0(p, lds);
    if (p.use_cg_sync) grid.sync(); else xcd_barrier(xb);
    for (int rep = 0; rep < REPS; ++rep) grid.sync();
    for (int rep = 0; rep < REP1; ++rep)
    { pg8::Gemm g; g.A = (const bf16_t*)(p.ws + WS_XN); g.Bt = (const bf16_t*)(p.ws + WS_W1); g.M = MROWS; g.N = NP; g.K = D;
      pg8::StaticOrder S; S.init(g.M, g.N, (int)gridDim.x, (int)blockIdx.x);
      EpiP E; E.P = (bf16_t*)(p.ws + WS_P);

#ifndef NO_GEMM
pg8::gemm_phase<EpiP, pg8::StaticOrder, false>((PG8_LAS unsigned char*)lds, g, S, E, nullptr);
#endif
 }
    xcd_barrier(xb);
    for (int rep = 0; rep < REP2; ++rep) phase2(p, lds);
#ifndef REP2B
#define REP2B 1
#endif
#ifndef REP3
#define REP3 1
#endif
#ifndef REP4
#define REP4 1
#endif
    for (int rep = 0; rep < REP2B; ++rep) phase2b(p, lds, (fwd > 0 && ((SKIPM >> 6) & 1)) ? 1 : 0);
    xcd_barrier(xb);
    const int nbk = (int)gridDim.x, bidk = (int)blockIdx.x, widk = (int)(threadIdx.x >> 6);
    const bool two = nbk > 16;
    if (RUNPH(4)) { pg8::Gemm g; g.A = (const bf16_t*)(p.ws + WS_YC); g.Bt = (const bf16_t*)(p.ws + WS_W2); g.M = two ? MPR : MTOK; g.N = D; g.K = D;
      pg8::StaticOrder S; S.init(g.M, g.N, nbk, bidk);
      pg8::EpiBf16<0> E; E.O = (bf16_t*)(p.ws + WS_XN); E.ldc = D; E.bias = nullptr; E.split_cols = 0; E.split_stride = 0;
#ifndef NO_GEMM
      pg8::gemm_phase<pg8::EpiBf16<0>, pg8::StaticOrder, false>((PG8_LAS unsigned char*)lds, g, S, E, nullptr);
#endif
    }
    xcd_barrier(xb);
    if (RUNPH(5)) {
    if (two) {
        pg8::Gemm g; g.A = (const bf16_t*)(p.ws + WS_YC) + (size_t)MPR * D; g.Bt = (const bf16_t*)(p.ws + WS_W2); g.M = MTOK - MPR; g.N = D; g.K = D;
        pg8::StaticOrder S; S.init(g.M, g.N, nbk, bidk);
        pg8::EpiBf16<0> E; E.O = (bf16_t*)(p.ws + WS_XN) + (size_t)MPR * D; E.ldc = D; E.bias = nullptr; E.split_cols = 0; E.split_stride = 0;
#ifndef NO_GEMM
        pg8::gemm_phase<pg8::EpiBf16<0>, pg8::StaticOrder, false>((PG8_LAS unsigned char*)lds, g, S, E, nullptr);
#endif
    }
    int r_begin = 0, r_end = two ? MPR : MTOK, fw = two ? (bidk - 16) * 8 + widk : bidk * 8 + widk, nwv = two ? (nbk - 16) * 8 : nbk * 8;
    if (two && bidk < 16) {
        pg8::StaticOrder S; S.init(MTOK - MPR, D, nbk, bidk); pg8::Unit u; (void)S.next(0, u);
        group_barrier((unsigned*)(p.ws + WS_BAR) + 3584 + 64 * u.pm, 4u * (unsigned)(fwd + 1));
        r_begin = MPR + u.pm * 256 + u.pn * 64; r_end = r_begin + 64; fw = widk; nwv = 8;
    }
    phase4(p, r_begin, r_end, fw, nwv);
    }
    }
}

extern "C" void kernel_launch(void* const* d_in, const int* in_sizes, int n_in, void* d_out, int out_size, void* d_ws, size_t ws_size, hipStream_t stream) {
    static int grid_blocks = 0;
    if (!grid_blocks) {
        int dev = 0, cus = 0, per_cu = 0;
        hipGetDevice(&dev); hipDeviceGetAttribute(&cus, hipDeviceAttributeMultiprocessorCount, dev);
        hipFuncSetAttribute((const void*)fwd_megakernel, hipFuncAttributeMaxDynamicSharedMemorySize, LDS_BYTES);
        hipOccupancyMaxActiveBlocksPerMultiprocessor(&per_cu, (const void*)fwd_megakernel, 512, LDS_BYTES);
        if (per_cu < 1) per_cu = 1;
        grid_blocks = cus * per_cu;
        if (ws_size < WS_END || n_in != 20) fprintf(stderr, "kernel_launch: unexpected sizes ws %zu n_in %d\n", ws_size, n_in);
    }
    (void)hipMemsetAsync((unsigned char*)d_ws + WS_BAR, 0, 65536, stream);
    Params p{};
    const float** pp = (const float**)&p;
    for (int i = 0; i < 20; ++i) pp[i] = (const float*)d_in[i];
    p.out = (float*)d_out; p.ws = (unsigned char*)d_ws;
    void* args[] = {&p};
    hipError_t e = hipLaunchCooperativeKernel((const void*)fwd_megakernel, dim3(grid_blocks), dim3(512), args, LDS_BYTES, stream);
    if (e != hipSuccess) fprintf(stderr, "cooperative launch failed: %s (grid %d)\n", hipGetErrorString(e), grid_blocks);
}
```
